# Optimizing an MI355X kernel written in HIP

```python
import math, functools
import jax, jax.numpy as jnp
from jax import lax
import numpy as np

D_MODEL = 2048
BATCH = 2
SEQ = 4096
DEPTH = 1

CHUNK = 64
D_LRU = 1024
LRU_HEADS = 16
LRU_HEAD_DIM = D_LRU // LRU_HEADS
LRU_CONV = 4
LRU_C = 8.0
D_SC = 1024
SC_CONV = 3
D_FF = 5632
FFN_CONV = 3
N_BRANCH = 2
EPS = 1e-6
IN_COLS = 2 * D_LRU + 3 * D_SC + N_BRANCH * D_MODEL

kernel_name = "hybrid_rglru_shortconv_convffn_block"


def rmsnorm(x, g):
    xf = x.astype(jnp.float32)
    y = xf * lax.rsqrt(jnp.mean(xf * xf, axis=-1, keepdims=True) + EPS)
    return (y * g.astype(jnp.float32)).astype(x.dtype)


def causal_dwconv(x, w):
    k_w = w.shape[0]
    s = x.shape[1]
    xp = jnp.pad(x, ((0, 0), (k_w - 1, 0), (0, 0)))
    y = xp[:, 0:s] * w[0]
    for k in range(1, k_w):
        y = y + xp[:, k:k + s] * w[k]
    return y


def _lin_combine(left, right):
    a1, b1 = left
    a2, b2 = right
    return a1 * a2, a2 * b1 + b2


def rg_lru(x, w_a, b_a, w_x, b_x, lam):
    bsz, s, d = x.shape
    xf = x.astype(jnp.float32)
    xh = xf.reshape(bsz, s, LRU_HEADS, LRU_HEAD_DIM)
    r = jax.nn.sigmoid(jnp.einsum('bshi,hij->bshj', xh, w_a.astype(jnp.float32)).reshape(bsz, s, d) + b_a.astype(jnp.float32))
    i = jax.nn.sigmoid(jnp.einsum('bshi,hij->bshj', xh, w_x.astype(jnp.float32)).reshape(bsz, s, d) + b_x.astype(jnp.float32))
    log_a = -LRU_C * jax.nn.softplus(-lam.astype(jnp.float32)) * r
    a = jnp.exp(log_a)
    u = jnp.sqrt(-jnp.expm1(2.0 * log_a)) * (i * xf)
    n_chunks = s // CHUNK
    a_c = a.reshape(bsz, n_chunks, CHUNK, d).transpose(1, 0, 2, 3)
    u_c = u.reshape(bsz, n_chunks, CHUNK, d).transpose(1, 0, 2, 3)

    def step(h0, inp):
        ac, uc = inp
        a_cum, b_cum = lax.associative_scan(_lin_combine, (ac, uc), axis=1)
        h = a_cum * h0[:, None, :] + b_cum
        return h[:, -1], h

    h_init = jnp.zeros((bsz, d), jnp.float32)
    _, hs = lax.scan(step, h_init, (a_c, u_c))
    return hs.transpose(1, 0, 2, 3).reshape(bsz, s, d).astype(x.dtype)


def setup_inputs(seed: int = 0) -> dict:
    key = jax.random.key(seed)
    ks = jax.random.split(key, 20)
    f32 = jnp.float32
    nrm = lambda k, shp, fan: jax.random.normal(k, shp, f32) * (fan ** -0.5)
    a0 = jax.random.uniform(ks[9], (D_LRU,), f32, 0.9, 0.999)
    return {
        "x": jax.random.normal(ks[0], (BATCH, SEQ, D_MODEL), f32),
        "g_mix": 1.0 + 0.02 * jax.random.normal(ks[1], (D_MODEL,), f32),
        "w_in": nrm(ks[2], (D_MODEL, IN_COLS), D_MODEL),
        "lru_conv_w": nrm(ks[3], (LRU_CONV, D_LRU), LRU_CONV),
        "lru_conv_b": 0.01 * jax.random.normal(ks[4], (D_LRU,), f32),
        "lru_wa": nrm(ks[5], (LRU_HEADS, LRU_HEAD_DIM, LRU_HEAD_DIM), LRU_HEAD_DIM),
        "lru_ba": 0.01 * jax.random.normal(ks[6], (D_LRU,), f32),
        "lru_wx": nrm(ks[7], (LRU_HEADS, LRU_HEAD_DIM, LRU_HEAD_DIM), LRU_HEAD_DIM),
        "lru_bx": 0.01 * jax.random.normal(ks[8], (D_LRU,), f32),
        "lru_lambda": jnp.log(a0) - jnp.log1p(-a0),
        "lru_w_out": nrm(ks[10], (D_LRU, D_MODEL), D_LRU),
        "sc_conv_w": nrm(ks[11], (SC_CONV, D_SC), SC_CONV),
        "sc_w_out": nrm(ks[12], (D_SC, D_MODEL), D_SC),
        "w_o": nrm(ks[13], (D_MODEL, D_MODEL), D_MODEL),
        "g_ffn": 1.0 + 0.02 * jax.random.normal(ks[14], (D_MODEL,), f32),
        "ffn_w_up": nrm(ks[15], (D_MODEL, 2 * D_FF), D_MODEL),
        "ffn_conv_w": nrm(ks[16], (FFN_CONV, 2 * D_FF), FFN_CONV),
        "ffn_w_down": nrm(ks[17], (D_FF, D_MODEL), D_FF),
        "g_final": 1.0 + 0.02 * jax.random.normal(ks[18], (D_MODEL,), f32),
    }


def reference(x, g_mix, w_in, lru_conv_w, lru_conv_b, lru_wa, lru_ba, lru_wx, lru_bx,
              lru_lambda, lru_w_out, sc_conv_w, sc_w_out, w_o, g_ffn, ffn_w_up,
              ffn_conv_w, ffn_w_down, g_final):
    for _ in range(DEPTH):
        h = rmsnorm(x, g_mix)
        p = h @ w_in
        o = 0
        lru_x = p[..., o:o + D_LRU]; o += D_LRU
        lru_gate = p[..., o:o + D_LRU]; o += D_LRU
        sc_b = p[..., o:o + D_SC]; o += D_SC
        sc_c = p[..., o:o + D_SC]; o += D_SC
        sc_v = p[..., o:o + D_SC]; o += D_SC
        gate_lru = p[..., o:o + D_MODEL]; o += D_MODEL
        gate_sc = p[..., o:o + D_MODEL]

        xc = causal_dwconv(lru_x, lru_conv_w) + lru_conv_b
        y_lru = rg_lru(xc, lru_wa, lru_ba, lru_wx, lru_bx, lru_lambda)
        y_lru = (jax.nn.gelu(lru_gate) * y_lru) @ lru_w_out

        y_sc = (sc_b * causal_dwconv(sc_c * sc_v, sc_conv_w)) @ sc_w_out

        merged = jax.nn.sigmoid(gate_lru) * y_lru + jax.nn.sigmoid(gate_sc) * y_sc
        x = x + merged @ w_o

        h = rmsnorm(x, g_ffn)
        u = causal_dwconv(h @ ffn_w_up, ffn_conv_w)
        ff_gate, ff_val = u[..., :D_FF], u[..., D_FF:]
        x = x + (jax.nn.silu(ff_gate) * ff_val) @ ffn_w_down
    return rmsnorm(x, g_final)
```

```cpp
#include <hip/hip_runtime.h>
#include <hip/hip_cooperative_groups.h>
#include <cstdio>
namespace cg = cooperative_groups;

#ifndef NAIVE_KLOOP
#define NAIVE_KLOOP 0
#endif

#define LAS __attribute__((address_space(3)))
typedef unsigned short bf16_t;
typedef short bf16x8 __attribute__((ext_vector_type(8)));
typedef float f32x4 __attribute__((ext_vector_type(4)));
typedef float f32x2 __attribute__((ext_vector_type(2)));
typedef unsigned u32x4 __attribute__((ext_vector_type(4)));
typedef unsigned u32x2 __attribute__((ext_vector_type(2)));

constexpr int SEQ = 4096, NB = 2, MTOK = NB * SEQ;
constexpr int D = 2048, DL = 1024, DS = 1024, DFF = 5632, NUP = 2 * DFF, NIN = 2 * DL + 3 * DS + 2 * D;
constexpr int NH = 16, HD = 64;
constexpr float EPS = 1e-6f;
constexpr int PC_LX = 0, PC_LG = 1024, PC_SB = 2048, PC_SC = 3072, PC_SV = 4096, PC_GL = 5120, PC_GS = 7168;
constexpr int LNCH = 8;

constexpr size_t OFF_WINT = 0;
constexpr size_t OFF_WLRU = OFF_WINT + (size_t)NIN * D * 2;
constexpr size_t OFF_WSC  = OFF_WLRU + (size_t)D * DL * 2;
constexpr size_t OFF_WO   = OFF_WSC + (size_t)D * DS * 2;
constexpr size_t OFF_HREG = OFF_WO + (size_t)D * D * 2;
constexpr size_t OFF_WUP  = (size_t)MTOK * DFF * 2;
constexpr size_t OFF_WDN  = OFF_WUP + (size_t)NUP * D * 2;
constexpr size_t OFF_P    = OFF_WDN + (size_t)D * DFF * 2;
constexpr size_t OFF_MRG  = OFF_P + (size_t)MTOK * NIN * 2;
constexpr size_t OFF_FF   = OFF_P;
constexpr size_t OFF_SQ   = OFF_MRG + (size_t)MTOK * D * 2;
constexpr size_t OFF_LA   = OFF_SQ + (size_t)MTOK * 32 * 4;
constexpr size_t OFF_LH   = OFF_LA + (size_t)NB * LNCH * DL * 4;
constexpr size_t OFF_HALO = OFF_LH + (size_t)NB * LNCH * DL * 4;
constexpr size_t OFF_SQ2  = OFF_HALO + (size_t)(MTOK / 256) * 4 * NUP * 4;
constexpr size_t OFF_CNT  = OFF_SQ2 + (size_t)(MTOK / 256) * 8 * 256 * 4;
constexpr size_t OFF_BAR  = OFF_CNT + (size_t)64 * 256;
constexpr size_t WS_END   = OFF_BAR + 3456 * 4;
static_assert(OFF_HREG + (size_t)MTOK * D * 2 <= OFF_WUP, "ws overlap");

constexpr int LDS_BYTES = 160 * 1024;

struct Params { const float* in[19]; float* out; unsigned char* ws; };

__device__ __forceinline__ unsigned cvt_pk_bf16(float lo, float hi) { unsigned r; asm volatile("v_cvt_pk_bf16_f32 %0, %1, %2" : "=v"(r) : "v"(lo), "v"(hi)); return r; }
__device__ __forceinline__ float bf_lo(unsigned w) { return __uint_as_float(w << 16); }
__device__ __forceinline__ float bf_hi(unsigned w) { return __uint_as_float(w & 0xffff0000u); }
__device__ __forceinline__ void unpack8(const u32x4 w, float (&f)[8]) {
    f[0] = bf_lo(w.x); f[1] = bf_hi(w.x); f[2] = bf_lo(w.y); f[3] = bf_hi(w.y); f[4] = bf_lo(w.z); f[5] = bf_hi(w.z); f[6] = bf_lo(w.w); f[7] = bf_hi(w.w);
}
__device__ __forceinline__ u32x4 pack8(const float (&f)[8]) { u32x4 o; o.x = cvt_pk_bf16(f[0], f[1]); o.y = cvt_pk_bf16(f[2], f[3]); o.z = cvt_pk_bf16(f[4], f[5]); o.w = cvt_pk_bf16(f[6], f[7]); return o; }
__device__ __forceinline__ float fast_sigmoid(float x) { return __builtin_amdgcn_rcpf(1.0f + __builtin_amdgcn_exp2f(-1.4426950408889634f * x)); }
__device__ __forceinline__ float gelu_tanh(float x) { const float u = 1.5957691216057308f * (x + 0.044715f * x * x * x); return x * fast_sigmoid(u); }
__device__ __forceinline__ float wave_sum(float v) {
#pragma unroll
    for (int o = 1; o < 64; o <<= 1) v += __shfl_xor(v, o);
    return v;
}
#define LDS_WAIT() asm volatile("s_waitcnt lgkmcnt(0)" ::: "memory")
__device__ __forceinline__ __amdgpu_buffer_rsrc_t wt_rsrc(void* base, size_t bytes) { return __builtin_amdgcn_make_buffer_rsrc(base, 0, (int)bytes, 0x00020000); }
__device__ __forceinline__ void store16_wt(__amdgpu_buffer_rsrc_t r, size_t byte_off, u32x4 v) { __builtin_amdgcn_raw_buffer_store_b128(v, r, (unsigned)byte_off, 0, 16); }
__device__ __forceinline__ int x1b_phys_row(int r) { const int s = r & 63; return (r & ~63) + 16 * (s & 3) + (s >> 2); }
__device__ __forceinline__ int opaque_tid() { int t = threadIdx.x; asm volatile("" : "+v"(t)); return t; }

namespace pg8 {
constexpr int BM = 256, BK = 64, HALF = 128, HTB = HALF * BK * 2, STAGE_BYTES = 8 * HTB, NXCD = 8, WGM = 8;
__host__ __device__ __forceinline__ int lds_byte(int r, int c) { const int st = (r >> 4) * 2 + (c >> 5), rr = r & 15, cc = c & 31, ob = rr * 64 + cc * 2; return st * 1024 + (ob ^ (((ob >> 9) & 1) << 5)); }
__host__ __device__ __forceinline__ void stage_rc(int b, int& R, int& C) { const int st = b / 1024, sb = b % 1024, swz = sb ^ (((sb >> 9) & 1) << 5); R = (st >> 1) * 16 + swz / 64; C = (st & 1) * 32 + (swz % 64) / 2; }
__host__ __device__ __forceinline__ int perm32(int rho) { const int n = rho >> 4, i = rho & 15; return 8 * (i >> 2) + 4 * n + (i & 3); }

struct Unit { int pm, pn; };
struct Gemm { const bf16_t* A; const bf16_t* Bt; int M, N, K; const bf16_t* A2; const bf16_t* Bt2; };

struct StaticOrder {
    int nM, nN, nwg, G, c;
    __host__ __device__ void init(int M, int N, int G_, int c_) { nM = M / BM; nN = N / BM; nwg = nM * nN; G = G_; c = c_; }
    __host__ __device__ bool next(int i, Unit& u) const {
        const long L = (long)i * G + c; if (L >= nwg) return false;
        int wgid = (int)L; { const int q = nwg / NXCD, r = nwg % NXCD, xcd = wgid % NXCD, off = wgid / NXCD; wgid = (xcd < r ? xcd * (q + 1) : r * (q + 1) + (xcd - r) * q) + off; }
        const int nig = WGM * nN, gid = wgid / nig, fm = gid * WGM, gsz = (nM - fm) < WGM ? (nM - fm) : WGM;
        u.pm = fm + ((wgid % nig) % gsz); u.pn = (wgid % nig) / gsz; return true;
    }
    __device__ __forceinline__ void a_ready(const Unit&) const {}
    __device__ __forceinline__ void done(const Unit&) const {}
};

#if !NAIVE_KLOOP
template <class Epi, class Sched, int NSEG = 1>
__device__ __forceinline__ void gemm_phase(LAS unsigned char* lds, const Gemm g, const Sched& S, const Epi& E) {
    const int tid = opaque_tid(), wid = __builtin_amdgcn_readfirstlane(tid >> 6), lane = tid & 63, wr = wid >> 2, wc = wid & 3, fr = lane & 15, fq = lane >> 4;
    const int K = g.K, nt = K / BK;
    unsigned voffA[2], voffB[2];
#pragma unroll
    for (int i = 0; i < 2; ++i) { int R, C; stage_rc(tid * 16 + i * 8192, R, C); const int Rb = Epi::PERM ? ((R & ~31) + perm32(R & 31)) : R;
        voffA[i] = (unsigned)(R * K + C) * 2u; voffB[i] = (unsigned)(Rb * K + C) * 2u; }
    const size_t kstep = (size_t)(BK * 2);
    const size_t hstep = (size_t)HALF * K * 2;
    const size_t tstep = 2 * hstep;
    const unsigned ldsw = (unsigned)wid * 1024u;
    const int aoff = lds_byte(wr * 64 + fr, fq * 8), boff = lds_byte(wc * 32 + fr, fq * 8);
#define PG8_SA(b, h) (((b) * 2 + (h)) * HTB)
#define PG8_SB(b, h) ((4 + (b) * 2 + (h)) * HTB)
#define PG8_STAGE(bufoff, gbase, voff) do { _Pragma("unroll") for (int _i = 0; _i < 2; ++_i) \
        __builtin_amdgcn_global_load_lds((const unsigned*)((const char*)(gbase) + (voff)[_i]), (LAS unsigned*)(lds + (bufoff) + ldsw + _i * 8192), 16, 0, 0); } while (0)
#define PG8_LDA(dst, b, h) do { _Pragma("unroll") for (int m = 0; m < 4; ++m) _Pragma("unroll") for (int k = 0; k < 2; ++k) dst[m][k] = *(const LAS bf16x8*)(lds + PG8_SA(b, h) + aoff + m * 2048 + k * 1024); } while (0)
#define PG8_LDB(dst, b, h) do { _Pragma("unroll") for (int n = 0; n < 2; ++n) _Pragma("unroll") for (int k = 0; k < 2; ++k) dst[n][k] = *(const LAS bf16x8*)(lds + PG8_SB(b, h) + boff + n * 2048 + k * 1024); } while (0)
#define PG8_MMA(ai, bj, At, Bt) do { __builtin_amdgcn_s_setprio(1); _Pragma("unroll") for (int m = 0; m < 4; ++m) _Pragma("unroll") for (int n = 0; n < 2; ++n) _Pragma("unroll") for (int k = 0; k < 2; ++k) \
        acc[ai][bj][m][n] = __builtin_amdgcn_mfma_f32_16x16x32_bf16(Bt[n][k], At[m][k], acc[ai][bj][m][n], 0, 0, 0); __builtin_amdgcn_s_setprio(0); } while (0)
#define PG8_WAIT_V(n) asm volatile("s_waitcnt vmcnt(" #n ")" ::: "memory")
#define PG8_WAIT_L(n) asm volatile("s_waitcnt lgkmcnt(" #n ")" ::: "memory")
#define PG8_BAR __builtin_amdgcn_s_barrier()
#define PG8_SCHED __builtin_amdgcn_sched_barrier(0)
    Unit cur, nxt; int ui = 0;
    if (!S.next(0, cur)) return;
    f32x4 acc[2][2][4][2];
#pragma unroll
    for (int a = 0; a < 2; ++a)
#pragma unroll
        for (int b = 0; b < 2; ++b)
#pragma unroll
            for (int m = 0; m < 4; ++m)
#pragma unroll
                for (int n = 0; n < 2; ++n) acc[a][b][m][n] = (f32x4){0.f, 0.f, 0.f, 0.f};
    bf16x8 At[4][2], B0[2][2], B1[2][2];
    const char* cA = (const char*)g.A + (size_t)cur.pm * tstep; const char* cB = (const char*)g.Bt + (size_t)cur.pn * tstep;
    S.a_ready(cur);
    PG8_STAGE(PG8_SB(0, 0), cB, voffB); PG8_STAGE(PG8_SA(0, 0), cA, voffA); PG8_STAGE(PG8_SB(0, 1), cB + hstep, voffB); PG8_STAGE(PG8_SA(0, 1), cA + hstep, voffA);
    if (wr == 1) PG8_BAR;
    PG8_WAIT_V(4); PG8_BAR;
    PG8_STAGE(PG8_SB(1, 0), cB + kstep, voffB); PG8_STAGE(PG8_SA(1, 0), cA + kstep, voffA); PG8_STAGE(PG8_SB(1, 1), cB + hstep + kstep, voffB);
    PG8_WAIT_V(6); PG8_BAR;
#define PG8_KLOOP(KA_, KB_, KNA_, KNB_) \
        for (int t = 0; t < nt; t += 2) { \
            const bool last = (t == nt - 2); \
            const char* a1 = KA_ + (size_t)(t + 1) * kstep; \
            const char* a2 = last ? KNA_ : KA_ + (size_t)(t + 2) * kstep; const char* b2 = last ? KNB_ : KB_ + (size_t)(t + 2) * kstep; \
            const char* a3 = a2 + kstep; const char* b3 = b2 + kstep; \
            PG8_LDB(B0, 0, 0); PG8_SCHED; PG8_LDA(At, 0, 0); PG8_STAGE(PG8_SA(1, 1), a1 + hstep, voffA); \
            PG8_WAIT_L(8); PG8_BAR; PG8_WAIT_L(0); PG8_MMA(0, 0, At, B0); PG8_BAR; PG8_SCHED; \
            PG8_LDB(B1, 0, 1); PG8_STAGE(PG8_SB(0, 0), b2, voffB); \
            PG8_BAR; PG8_WAIT_L(0); PG8_MMA(0, 1, At, B1); PG8_BAR; \
            PG8_LDA(At, 0, 1); PG8_STAGE(PG8_SA(0, 0), a2, voffA); \
            PG8_BAR; PG8_WAIT_L(0); PG8_MMA(1, 0, At, B0); PG8_BAR; PG8_SCHED; \
            PG8_STAGE(PG8_SB(0, 1), b2 + hstep, voffB); \
            PG8_WAIT_V(6); PG8_BAR; PG8_MMA(1, 1, At, B1); PG8_BAR; \
            PG8_LDB(B0, 1, 0); PG8_SCHED; PG8_LDA(At, 1, 0); PG8_STAGE(PG8_SA(0, 1), a2 + hstep, voffA); \
            PG8_WAIT_L(8); PG8_BAR; PG8_WAIT_L(0); PG8_MMA(0, 0, At, B0); PG8_BAR; PG8_SCHED; \
            PG8_LDB(B1, 1, 1); PG8_STAGE(PG8_SB(1, 0), b3, voffB); \
            PG8_BAR; PG8_WAIT_L(0); PG8_MMA(0, 1, At, B1); PG8_BAR; \
            PG8_LDA(At, 1, 1); PG8_STAGE(PG8_SA(1, 0), a3, voffA); \
            PG8_BAR; PG8_WAIT_L(0); PG8_MMA(1, 0, At, B0); PG8_BAR; PG8_SCHED; \
            PG8_STAGE(PG8_SB(1, 1), b3 + hstep, voffB); \
            PG8_WAIT_V(6); PG8_BAR; PG8_MMA(1, 1, At, B1); PG8_BAR; \
        }
    for (;;) {
        const bool has_next = S.next(ui + 1, nxt);
        if constexpr (NSEG == 2) {
            const char* cA2 = (const char*)g.A2 + (size_t)cur.pm * tstep; const char* cB2 = (const char*)g.Bt2 + (size_t)cur.pn * tstep;
            PG8_KLOOP(cA, cB, cA2, cB2)
            { const int t2 = opaque_tid(), w2 = __builtin_amdgcn_readfirstlane(t2 >> 6), l2 = t2 & 63; E.mid(acc, cur, w2 >> 2, w2 & 3, l2 & 15, l2 >> 4); }
            const char* nA = has_next ? (const char*)g.A + (size_t)nxt.pm * tstep : cA2; const char* nB = has_next ? (const char*)g.Bt + (size_t)nxt.pn * tstep : cB2;
            PG8_KLOOP(cA2, cB2, nA, nB)
            cA = nA; cB = nB;
        } else {
            const char* nA = has_next ? (const char*)g.A + (size_t)nxt.pm * tstep : cA; const char* nB = has_next ? (const char*)g.Bt + (size_t)nxt.pn * tstep : cB;
            PG8_KLOOP(cA, cB, nA, nB)
            cA = nA; cB = nB;
        }
        if constexpr (!Epi::AFTER_DRAIN) { const int t2 = opaque_tid(), w2 = __builtin_amdgcn_readfirstlane(t2 >> 6), l2 = t2 & 63; E(acc, cur, w2 >> 2, w2 & 3, l2 & 15, l2 >> 4); }
        S.done(cur);
        if (!has_next) break;
#pragma unroll
        for (int a = 0; a < 2; ++a)
#pragma unroll
            for (int b = 0; b < 2; ++b)
#pragma unroll
                for (int m = 0; m < 4; ++m)
#pragma unroll
                    for (int n = 0; n < 2; ++n) acc[a][b][m][n] = (f32x4){0.f, 0.f, 0.f, 0.f};
        cur = nxt; ++ui;
    }
    PG8_WAIT_V(0);
    if (wr == 0) PG8_BAR;
    PG8_BAR;
    if constexpr (Epi::AFTER_DRAIN) E.fused(acc, cur, lds);
#undef PG8_KLOOP
#undef PG8_SA
#undef PG8_SB
#undef PG8_STAGE
#undef PG8_LDA
#undef PG8_LDB
#undef PG8_MMA
#undef PG8_WAIT_V
#undef PG8_WAIT_L
#undef PG8_BAR
#undef PG8_SCHED
}
#else
template <class Epi, class Sched, int NSEG = 1>
__device__ __forceinline__ void gemm_phase(LAS unsigned char* lds, const Gemm g, const Sched& S, const Epi& E) {
    const int tid = threadIdx.x, wid = tid >> 6, lane = tid & 63, wr = wid >> 2, wc = wid & 3, fr = lane & 15, fq = lane >> 4;
    const int K = g.K;
    Unit cur;
    for (int ui = 0; S.next(ui, cur); ++ui) {
        f32x4 acc[2][2][4][2];
#pragma unroll
        for (int a = 0; a < 2; ++a)
#pragma unroll
            for (int b = 0; b < 2; ++b)
#pragma unroll
                for (int m = 0; m < 4; ++m)
#pragma unroll
                    for (int n = 0; n < 2; ++n) acc[a][b][m][n] = (f32x4){0.f, 0.f, 0.f, 0.f};
        const bf16_t* Ab = g.A + (size_t)(cur.pm * BM + wr * 64 + fr) * K;
        const bf16_t* Bb = g.Bt + (size_t)(cur.pn * BM + wc * 32 + 8 * fq) * K;
        for (int k0 = 0; k0 < K; k0 += 2) {
            float a0[2][4], a1[2][4];
#pragma unroll
            for (int ai = 0; ai < 2; ++ai)
#pragma unroll
                for (int m = 0; m < 4; ++m) { const unsigned w = *(const unsigned*)(Ab + (size_t)(ai * HALF + m * 16) * K + k0); a0[ai][m] = bf_lo(w); a1[ai][m] = bf_hi(w); }
#pragma unroll
            for (int bj = 0; bj < 2; ++bj)
#pragma unroll
                for (int n = 0; n < 2; ++n)
#pragma unroll
                    for (int j = 0; j < 4; ++j) { const unsigned w = *(const unsigned*)(Bb + (size_t)(bj * HALF + 4 * n + j) * K + k0); const float b0 = bf_lo(w), b1 = bf_hi(w);
#pragma unroll
                        for (int ai = 0; ai < 2; ++ai)
#pragma unroll
                            for (int m = 0; m < 4; ++m) acc[ai][bj][m][n][j] += a0[ai][m] * b0 + a1[ai][m] * b1; }
        }
        if constexpr (Epi::AFTER_DRAIN) { __syncthreads(); E.fused(acc, cur, lds); } else E(acc, cur, wr, wc, fr, fq);
    }
    __syncthreads();
}
#endif
}
using pg8::Unit;

#define EPI_ROWS_BEGIN \
    const int row0 = u.pm * 256 + wr * 64 + fr, col0 = u.pn * 256 + wc * 32 + 8 * fq; \
    _Pragma("unroll") for (int ai = 0; ai < 2; ++ai) _Pragma("unroll") for (int m = 0; m < 4; ++m) { const int row = row0 + ai * 128 + m * 16;
#define EPI_COLS_BEGIN \
    _Pragma("unroll") for (int bj = 0; bj < 2; ++bj) { const int col = col0 + bj * 128; const f32x4 v0 = acc[ai][bj][m][0], v1 = acc[ai][bj][m][1]; \
        float v[8] = {v0[0], v0[1], v0[2], v0[3], v1[0], v1[1], v1[2], v1[3]};
#define EPI_END } }

struct EpiIn {
    static constexpr bool PERM = true, AFTER_DRAIN = false;
    bf16_t* P;
    __device__ __forceinline__ void operator()(f32x4 (&acc)[2][2][4][2], const Unit& u, int wr, int wc, int fr, int fq) const {
        const int mode = (u.pn < 4) ? 0 : (u.pn < 8) ? 1 : (u.pn < 20) ? 0 : 2;
        const __amdgpu_buffer_rsrc_t rs = wt_rsrc(P, (size_t)MTOK * NIN * 2);
        EPI_ROWS_BEGIN
        EPI_COLS_BEGIN
            if (mode == 1) {
#pragma unroll
                for (int j = 0; j < 8; ++j) v[j] = gelu_tanh(v[j]);
            } else if (mode == 2) {
#pragma unroll
                for (int j = 0; j < 8; ++j) v[j] = fast_sigmoid(v[j]);
            }
            store16_wt(rs, ((size_t)row * NIN + col) * 2, pack8(v));
        EPI_END
    }
};
struct EpiMix {
    static constexpr bool PERM = true, AFTER_DRAIN = false;
    const bf16_t* P; bf16_t* MRG;
    __device__ __forceinline__ void mid(f32x4 (&acc)[2][2][4][2], const Unit& u, int wr, int wc, int fr, int fq) const {
        const int row0 = u.pm * 256 + wr * 64 + fr, col0 = u.pn * 256 + wc * 32 + 8 * fq;
#pragma unroll
        for (int ai = 0; ai < 2; ++ai)
#pragma unroll
            for (int m = 0; m < 4; ++m) { const int row = row0 + ai * 128 + m * 16;
#pragma unroll
                for (int bj = 0; bj < 2; ++bj) { const int col = col0 + bj * 128;
                    float gl[8], gs[8]; unpack8(*(const u32x4*)(P + (size_t)row * NIN + PC_GL + col), gl); unpack8(*(const u32x4*)(P + (size_t)row * NIN + PC_GS + col), gs);
#pragma unroll
                    for (int j = 0; j < 8; ++j) { const float rt = gl[j] * __builtin_amdgcn_rcpf(fmaxf(gs[j], 1e-30f)); if (j < 4) acc[ai][bj][m][0][j] *= rt; else acc[ai][bj][m][1][j - 4] *= rt; } }
                if (m == 3) asm volatile("" ::: "memory"); }
    }
    __device__ __forceinline__ void operator()(f32x4 (&acc)[2][2][4][2], const Unit& u, int wr, int wc, int fr, int fq) const {
        const int row0 = u.pm * 256 + wr * 64 + fr, col0 = u.pn * 256 + wc * 32 + 8 * fq;
        const __amdgpu_buffer_rsrc_t rs = wt_rsrc(MRG, (size_t)MTOK * D * 2);
#pragma unroll
        for (int ai = 0; ai < 2; ++ai) {
            u32x4 gr[4][2];
#pragma unroll
            for (int m = 0; m < 4; ++m)
#pragma unroll
                for (int bj = 0; bj < 2; ++bj) gr[m][bj] = *(const u32x4*)(P + (size_t)(row0 + ai * 128 + m * 16) * NIN + PC_GS + col0 + bj * 128);
#pragma unroll
            for (int m = 0; m < 4; ++m)
#pragma unroll
                for (int bj = 0; bj < 2; ++bj) asm volatile("" : "+v"(gr[m][bj]));
#pragma unroll
            for (int m = 0; m < 4; ++m) { const int row = row0 + ai * 128 + m * 16;
#pragma unroll
                for (int bj = 0; bj < 2; ++bj) { const int col = col0 + bj * 128; const f32x4 v0 = acc[ai][bj][m][0], v1 = acc[ai][bj][m][1];
                    float v[8] = {v0[0], v0[1], v0[2], v0[3], v1[0], v1[1], v1[2], v1[3]};
                    float gs[8]; unpack8(gr[m][bj], gs);
#pragma unroll
                    for (int j = 0; j < 8; ++j) v[j] *= fmaxf(gs[j], 1e-30f);
                    *(u32x4*)(MRG + (size_t)row * D + col) = pack8(v); } }
            asm volatile("" ::: "memory");
        }
    }
};
struct EpiO {
    static constexpr bool PERM = true, AFTER_DRAIN = false;
    const float* X; bf16_t* X1B; float* SQ;
    __device__ __forceinline__ void operator()(f32x4 (&acc)[2][2][4][2], const Unit& u, int wr, int wc, int fr, int fq) const {
        const int row0 = u.pm * 256 + wr * 64 + fr, col0 = u.pn * 256 + wc * 32 + 8 * fq;
        const __amdgpu_buffer_rsrc_t rs = wt_rsrc(X1B, (size_t)MTOK * D * 2);
#pragma unroll
        for (int ai = 0; ai < 2; ++ai)
#pragma unroll
            for (int mp = 0; mp < 2; ++mp) {
                f32x4 xr[2][2][2];
#pragma unroll
                for (int mm = 0; mm < 2; ++mm)
#pragma unroll
                    for (int bj = 0; bj < 2; ++bj) { const float* xp = X + (size_t)(row0 + ai * 128 + (2 * mp + mm) * 16) * D + col0 + bj * 128; xr[mm][bj][0] = *(const f32x4*)xp; xr[mm][bj][1] = *(const f32x4*)(xp + 4); }
#pragma unroll
                for (int mm = 0; mm < 2; ++mm)
#pragma unroll
                    for (int bj = 0; bj < 2; ++bj) asm volatile("" : "+v"(xr[mm][bj][0]), "+v"(xr[mm][bj][1]));
#pragma unroll
                for (int mm = 0; mm < 2; ++mm) { const int m = 2 * mp + mm, row = row0 + ai * 128 + m * 16; float ss = 0.f;
#pragma unroll
                    for (int bj = 0; bj < 2; ++bj) { const int col = col0 + bj * 128;
                        const f32x4 a = acc[ai][bj][m][0] + xr[mm][bj][0], b = acc[ai][bj][m][1] + xr[mm][bj][1];
                        float v[8] = {a[0], a[1], a[2], a[3], b[0], b[1], b[2], b[3]};
#pragma unroll
                        for (int j = 0; j < 8; ++j) ss += v[j] * v[j];
                        *(u32x4*)(X1B + (size_t)x1b_phys_row(row) * D + col) = pack8(v); }
                    ss += __shfl_xor(ss, 16); ss += __shfl_xor(ss, 32);
                    if (fq == 0) SQ[(size_t)row * 32 + u.pn * 4 + wc] = ss; }
                asm volatile("" ::: "memory");
            }
    }
};
__device__ __forceinline__ float dpp_shr1(float old, float src) { return __int_as_float(__builtin_amdgcn_update_dpp(__float_as_int(old), __float_as_int(src), 0x111, 0xf, 0xf, false)); }
__device__ __forceinline__ float dpp_shr2(float old, float src) { return __int_as_float(__builtin_amdgcn_update_dpp(__float_as_int(old), __float_as_int(src), 0x112, 0xf, 0xf, false)); }
__device__ __forceinline__ float dpp_shr1z(float src) { return __int_as_float(__builtin_amdgcn_update_dpp(0, __float_as_int(src), 0x111, 0xf, 0xf, true)); }
__device__ __forceinline__ float dpp_shr2z(float src) { return __int_as_float(__builtin_amdgcn_update_dpp(0, __float_as_int(src), 0x112, 0xf, 0xf, true)); }
__device__ __forceinline__ float dpp_ror1(float src) { return __int_as_float(__builtin_amdgcn_update_dpp(0, __float_as_int(src), 0x121, 0xf, 0xf, false)); }
__device__ __forceinline__ float dpp_ror2(float src) { return __int_as_float(__builtin_amdgcn_update_dpp(0, __float_as_int(src), 0x122, 0xf, 0xf, false)); }
struct EpiUpConv {
    static constexpr bool PERM = true, AFTER_DRAIN = false;
    const float* SQ; bf16_t* FF; const float* cw; float* HALO; LAS float* hal; int* last_pm; int* ui;
    __device__ __forceinline__ void operator()(f32x4 (&acc)[2][2][4][2], const Unit& u, int wr, int wc, int fr, int fq) const {
        const int tid = opaque_tid();
        LAS float* rsl = hal + 2048; LAS float* wl = rsl + 256 + 768 * (*ui);
        const int row0 = u.pm * 256 + wr * 64 + fr;
        const int ch0 = u.pn * 128 + wc * 32 + 8 * fq;
        if (tid < 256 && u.pm != *last_pm) {
            const f32x4* sp = (const f32x4*)(SQ + (size_t)(u.pm * 256 + tid) * 32);
            f32x4 t = sp[0];
#pragma unroll
            for (int i = 1; i < 8; ++i) t += sp[i];
            rsl[tid] = 1.0f / sqrtf(((t[0] + t[1]) + (t[2] + t[3])) * (1.0f / D) + EPS);
        }
        if (fr == 15) {
#pragma unroll
            for (int ai = 0; ai < 2; ++ai) { LAS float* h = hal + ((((2 * ai + wr) * 4 + wc) * 4 + fq) * 2) * 16;
#pragma unroll
                for (int bj = 0; bj < 2; ++bj)
#pragma unroll
                    for (int n = 0; n < 2; ++n) { *(LAS f32x4*)(h + bj * 8 + n * 4) = acc[ai][bj][2][n]; *(LAS f32x4*)(h + 16 + bj * 8 + n * 4) = acc[ai][bj][3][n]; } }
        }
        asm volatile("s_waitcnt lgkmcnt(0)" ::: "memory"); __builtin_amdgcn_s_barrier(); __builtin_amdgcn_s_barrier(); asm volatile("" ::: "memory");
        float r[2][4], rp62[2], rp63[2];
#pragma unroll
        for (int ai = 0; ai < 2; ++ai) {
            const int strip = 2 * ai + wr;
            const f32x4 rr = *(const LAS f32x4*)(rsl + 64 * strip + 4 * fr);
            r[ai][0] = rr[0]; r[ai][1] = rr[1]; r[ai][2] = rr[2]; r[ai][3] = rr[3];
            rp62[ai] = 0.f; rp63[ai] = 0.f;
            if (strip > 0) { rp62[ai] = rsl[64 * strip - 2]; rp63[ai] = rsl[64 * strip - 1]; }
        }
        if (wr == 0 && fr == 0) {
#pragma unroll
            for (int m = 0; m < 2; ++m) { float* g = HALO + (size_t)(u.pm * 4 + m) * NUP + u.pn * 256 + wc * 32 + 8 * fq;
#pragma unroll
                for (int bj = 0; bj < 2; ++bj) { *(f32x4*)(g + bj * 128) = acc[0][bj][m][0] * r[0][m]; *(f32x4*)(g + bj * 128 + 4) = acc[0][bj][m][1] * r[0][m]; } } }
        if (wr == 1 && fr == 15) {
#pragma unroll
            for (int m = 2; m < 4; ++m) { float* g = HALO + (size_t)(u.pm * 4 + m) * NUP + u.pn * 256 + wc * 32 + 8 * fq;
#pragma unroll
                for (int bj = 0; bj < 2; ++bj) { *(f32x4*)(g + bj * 128) = acc[1][bj][m][0] * r[1][m]; *(f32x4*)(g + bj * 128 + 4) = acc[1][bj][m][1] * r[1][m]; } } }
        asm volatile("" ::: "memory");
        const __amdgpu_buffer_rsrc_t ffrs = wt_rsrc(FF, (size_t)MTOK * DFF * 2);
#pragma unroll
        for (int ai = 0; ai < 2; ++ai) {
            const int strip = 2 * ai + wr;
#pragma unroll
            for (int bj = 0; bj < 2; ++bj)
#pragma unroll
                for (int n = 0; n < 2; ++n) {
                    const int tcol = bj * 128 + wc * 32 + 8 * fq + 4 * n;
                    const f32x4 w0 = *(const LAS f32x4*)(wl + tcol), w1 = *(const LAS f32x4*)(wl + 256 + tcol), w2 = *(const LAS f32x4*)(wl + 512 + tcol);
                    f32x4 q62 = {0.f, 0.f, 0.f, 0.f}, q63 = {0.f, 0.f, 0.f, 0.f};
                    if (strip > 0) { const LAS float* h = hal + ((((strip - 1) * 4 + wc) * 4 + fq) * 2) * 16 + bj * 8 + n * 4;
                        q62 = *(const LAS f32x4*)h * rp62[ai]; q63 = *(const LAS f32x4*)(h + 16) * rp63[ai]; }
                    LDS_WAIT(); __builtin_amdgcn_sched_barrier(0);
#pragma unroll
                    for (int j = 0; j < 4; ++j) {
                        const float c0 = acc[ai][bj][0][n][j] * r[ai][0], c1 = acc[ai][bj][1][n][j] * r[ai][1], c2 = acc[ai][bj][2][n][j] * r[ai][2], c3 = acc[ai][bj][3][n][j] * r[ai][3];
                        const float x3 = dpp_shr1(q63[j], c3), x2 = dpp_shr1(q62[j], c2);
                        float v0 = fmaf(w0[j], x2, fmaf(w1[j], x3, w2[j] * c0));
                        float v1 = fmaf(w0[j], x3, fmaf(w1[j], c0, w2[j] * c1));
                        float v2 = fmaf(w0[j], c0, fmaf(w1[j], c1, w2[j] * c2));
                        float v3 = fmaf(w0[j], c1, fmaf(w1[j], c2, w2[j] * c3));
                        asm volatile("" : "+v"(v0), "+v"(v1), "+v"(v2), "+v"(v3));
                        acc[ai][bj][0][n][j] = v0; acc[ai][bj][1][n][j] = v1; acc[ai][bj][2][n][j] = v2; acc[ai][bj][3][n][j] = v3;
                    }
                    asm volatile("" ::: "memory"); __builtin_amdgcn_sched_barrier(0);
                }
#pragma unroll
            for (int m = 0; m < 4; ++m) { const int row = u.pm * 256 + 64 * strip + 4 * fr + m;
                float o[8];
#pragma unroll
                for (int n = 0; n < 2; ++n)
#pragma unroll
                    for (int j = 0; j < 4; ++j) { const float g = acc[ai][0][m][n][j]; o[4 * n + j] = g * fast_sigmoid(g) * acc[ai][1][m][n][j]; }
                store16_wt(ffrs, ((size_t)row * DFF + ch0) * 2, pack8(o)); }
            asm volatile("" ::: "memory"); __builtin_amdgcn_sched_barrier(0);
        }
        *last_pm = u.pm; *ui += 1;
    }
};
__device__ __forceinline__ void ff_fixup(const float* HALO, const float* cw, bf16_t* FF, int pm) {
    if ((pm & 15) == 0) return;
    constexpr int NIT = DFF / 4;
    const int t0 = opaque_tid();
    f32x4 hg[3][4], hv[3][4], wg[3][3], wv[3][3];
#pragma unroll
    for (int q = 0; q < 3; ++q) {
        const int it = t0 + 512 * q, itc = it < NIT ? it : NIT - 1, c4 = itc * 4, pn = c4 >> 7, jj = c4 & 127, tc = pn * 256 + jj;
        const float* T0 = HALO + (size_t)((pm - 1) * 4 + 2) * NUP + tc;
        const float* H0 = HALO + (size_t)(pm * 4) * NUP + tc;
        hg[q][0] = *(const f32x4*)T0; hg[q][1] = *(const f32x4*)(T0 + NUP); hg[q][2] = *(const f32x4*)H0; hg[q][3] = *(const f32x4*)(H0 + NUP);
        hv[q][0] = *(const f32x4*)(T0 + 128); hv[q][1] = *(const f32x4*)(T0 + NUP + 128); hv[q][2] = *(const f32x4*)(H0 + 128); hv[q][3] = *(const f32x4*)(H0 + NUP + 128);
#pragma unroll
        for (int k = 0; k < 3; ++k) { wg[q][k] = *(const f32x4*)(cw + k * NUP + c4); wv[q][k] = *(const f32x4*)(cw + k * NUP + DFF + c4); }
    }
#pragma unroll
    for (int q = 0; q < 3; ++q) {
#pragma unroll
        for (int k = 0; k < 4; ++k) asm volatile("" : "+v"(hg[q][k]), "+v"(hv[q][k]));
#pragma unroll
        for (int k = 0; k < 3; ++k) asm volatile("" : "+v"(wg[q][k]), "+v"(wv[q][k]));
    }
#pragma unroll
    for (int q = 0; q < 3; ++q) {
        const int it = t0 + 512 * q;
        if (it < NIT) {
#pragma unroll
            for (int rsel = 0; rsel < 2; ++rsel) {
                float o[4];
#pragma unroll
                for (int j = 0; j < 4; ++j) { const float g = wg[q][0][j] * hg[q][rsel][j] + wg[q][1][j] * hg[q][rsel + 1][j] + wg[q][2][j] * hg[q][rsel + 2][j];
                    const float v = wv[q][0][j] * hv[q][rsel][j] + wv[q][1][j] * hv[q][rsel + 1][j] + wv[q][2][j] * hv[q][rsel + 2][j]; o[j] = g * fast_sigmoid(g) * v; }
                u32x2 w; w.x = cvt_pk_bf16(o[0], o[1]); w.y = cvt_pk_bf16(o[2], o[3]);
                *(u32x2*)(FF + (size_t)(pm * 256 + rsel) * DFF + it * 4) = w;
            }
        }
    }
}
struct EpiDnNorm {
    static constexpr bool PERM = true, AFTER_DRAIN = true;
    float* X; const bf16_t* X1B; const float* gfin; float* SQ2; unsigned* cnt;
    __device__ __forceinline__ void fused(f32x4 (&acc)[2][2][4][2], const Unit& u, LAS unsigned char* lds) const {
        const int tid = opaque_tid(), wid = __builtin_amdgcn_readfirstlane(tid >> 6), lane = tid & 63, wr = wid >> 2, wc = wid & 3, fr = lane & 15, fq = lane >> 4;
        LAS float* part = (LAS float*)lds;
        LAS float* rs = part + 1024;
        const int row0 = u.pm * 256 + wr * 64 + fr, col0 = u.pn * 256 + wc * 32 + 8 * fq;
#pragma unroll
        for (int ai = 0; ai < 2; ++ai) {
            u32x4 xr[4][2];
#pragma unroll
            for (int m = 0; m < 4; ++m)
#pragma unroll
                for (int bj = 0; bj < 2; ++bj) xr[m][bj] = *(const u32x4*)(X1B + (size_t)x1b_phys_row(row0 + ai * 128 + m * 16) * D + col0 + bj * 128);
#pragma unroll
            for (int m = 0; m < 4; ++m)
#pragma unroll
                for (int bj = 0; bj < 2; ++bj) asm volatile("" : "+v"(xr[m][bj]));
#pragma unroll
            for (int m = 0; m < 4; ++m) { float ss = 0.f;
#pragma unroll
                for (int bj = 0; bj < 2; ++bj) { float xv[8]; unpack8(xr[m][bj], xv);
                    acc[ai][bj][m][0] += (f32x4){xv[0], xv[1], xv[2], xv[3]}; acc[ai][bj][m][1] += (f32x4){xv[4], xv[5], xv[6], xv[7]};
                    const f32x4 a = acc[ai][bj][m][0], b = acc[ai][bj][m][1];
                    ss += (a[0] * a[0] + a[1] * a[1]) + (a[2] * a[2] + a[3] * a[3]) + (b[0] * b[0] + b[1] * b[1]) + (b[2] * b[2] + b[3] * b[3]); }
                ss += __shfl_xor(ss, 16); ss += __shfl_xor(ss, 32);
                if (fq == 0) part[(ai * 128 + wr * 64 + m * 16 + fr) * 4 + wc] = ss; }
        }
        __syncthreads();
        if (tid < 256) { const f32x4 q = *(const LAS f32x4*)(part + tid * 4);
            __hip_atomic_store(SQ2 + ((size_t)u.pm * 8 + u.pn) * 256 + tid, (q[0] + q[1]) + (q[2] + q[3]), __ATOMIC_RELAXED, __HIP_MEMORY_SCOPE_AGENT); }
        asm volatile("s_waitcnt vmcnt(0)" ::: "memory");
        __syncthreads();
        if (tid == 0) {
            __hip_atomic_fetch_add(cnt + 64 * u.pm, 1u, __ATOMIC_RELAXED, __HIP_MEMORY_SCOPE_AGENT);
            for (int spin = 0; spin < (1 << 24); ++spin) { if (__hip_atomic_load(cnt + 64 * u.pm, __ATOMIC_RELAXED, __HIP_MEMORY_SCOPE_AGENT) >= 8u) break; __builtin_amdgcn_s_sleep(2); }
        }
        __syncthreads();
        if (tid < 256) { float tot = 0.f;
#pragma unroll
            for (int q = 0; q < 8; ++q) tot += __hip_atomic_load(SQ2 + ((size_t)u.pm * 8 + q) * 256 + tid, __ATOMIC_RELAXED, __HIP_MEMORY_SCOPE_AGENT);
            rs[tid] = 1.0f / sqrtf(tot * (1.0f / D) + EPS); }
        __syncthreads();
        f32x4 g[2][2];
#pragma unroll
        for (int bj = 0; bj < 2; ++bj) { g[bj][0] = *(const f32x4*)(gfin + col0 + bj * 128); g[bj][1] = *(const f32x4*)(gfin + col0 + bj * 128 + 4); }
#pragma unroll
        for (int ai = 0; ai < 2; ++ai)
#pragma unroll
            for (int m = 0; m < 4; ++m) { const int rl = ai * 128 + wr * 64 + m * 16 + fr; const float r = rs[rl]; float* o = X + (size_t)(u.pm * 256 + rl) * D + col0;
#pragma unroll
                for (int bj = 0; bj < 2; ++bj) { *(f32x4*)(o + bj * 128) = acc[ai][bj][m][0] * r * g[bj][0]; *(f32x4*)(o + bj * 128 + 4) = acc[ai][bj][m][1] * r * g[bj][1]; } }
    }
};

template <bool NTOUT>
__device__ __forceinline__ void p0_item64(const float* __restrict__ W, int K, int N, bf16_t* __restrict__ WT, const float* __restrict__ gk, LAS float* scr, int kb, int nb, int out_row0, int lane) {
    const int k0 = 64 * kb, n0 = 64 * nb, kq = lane >> 4, nq = 4 * (lane & 15);
    f32x4 v[16];
#pragma unroll
    for (int i = 0; i < 16; ++i) v[i] = __builtin_nontemporal_load((const f32x4*)(W + (size_t)(k0 + 4 * i + kq) * N + n0 + nq));
    if (gk) {
#pragma unroll
        for (int i = 0; i < 16; ++i) v[i] *= gk[k0 + 4 * i + kq];
    }
#pragma unroll
    for (int i = 0; i < 16; ++i) { LAS float* d = scr + (4 * i + kq) * 65 + nq; d[0] = v[i][0]; d[1] = v[i][1]; d[2] = v[i][2]; d[3] = v[i][3]; }
    LDS_WAIT();
    const int c = lane & 7;
#pragma unroll
    for (int j = 0; j < 8; ++j) { const int n = (lane >> 3) + 8 * j; const LAS float* s = scr + (8 * c) * 65 + n;
        u32x4 o; o.x = cvt_pk_bf16(s[0 * 65], s[1 * 65]); o.y = cvt_pk_bf16(s[2 * 65], s[3 * 65]); o.z = cvt_pk_bf16(s[4 * 65], s[5 * 65]); o.w = cvt_pk_bf16(s[6 * 65], s[7 * 65]);
        if (NTOUT) __builtin_nontemporal_store(o, (u32x4*)(WT + (size_t)(out_row0 + n) * K + k0 + 8 * c)); else *(u32x4*)(WT + (size_t)(out_row0 + n) * K + k0 + 8 * c) = o; }
    LDS_WAIT();
}
template <bool UPPERM, bool NTOUT = false>
__device__ __forceinline__ void convert_matrix(const float* W, int K, int N, bf16_t* WT, const float* gk, LAS unsigned char* lds, int wk, int nworkers) {
    const int tid = opaque_tid(), lane = tid & 63, wave = tid >> 6;
    LAS float* scr = (LAS float*)(lds + wave * 16640);
    const int nblk = N / 64, items = (K / 64) * nblk;
    for (int it = wk * 8 + wave; it < items; it += nworkers * 8) {
        const int kb = it / nblk, nb = it % nblk;
        int orow = 64 * nb;
        if (UPPERM) { const int bj = nb / (DFF / 64), rem = nb % (DFF / 64); orow = 256 * (rem >> 1) + 128 * bj + 64 * (rem & 1); }
        p0_item64<NTOUT>(W, K, N, WT, gk, scr, kb, nb, orow, lane);
    }
}

__device__ __forceinline__ void phase0(const Params& p, LAS unsigned char* lds) {
    const int tid = opaque_tid(), lane = tid & 63, wave = tid >> 6;
    const int gw = blockIdx.x * 8 + wave, NGW = gridDim.x * 8;
    unsigned char* ws = p.ws;
    const float* x = p.in[0]; const float* g = p.in[1]; bf16_t* H = (bf16_t*)(ws + OFF_HREG);
    for (int m = gw * 2; m < MTOK; m += NGW * 2) {
        const f32x4* xr = (const f32x4*)(x + (size_t)m * D) + lane; const f32x4* gr = (const f32x4*)g + lane;
        f32x4 v[2][8]; float s0 = 0.f, s1 = 0.f;
#pragma unroll
        for (int j = 0; j < 8; ++j) { v[0][j] = __builtin_nontemporal_load(xr + 64 * j); v[1][j] = __builtin_nontemporal_load(xr + 512 + 64 * j); }
#pragma unroll
        for (int j = 0; j < 8; ++j) { s0 += (v[0][j][0] * v[0][j][0] + v[0][j][1] * v[0][j][1]) + (v[0][j][2] * v[0][j][2] + v[0][j][3] * v[0][j][3]);
                                      s1 += (v[1][j][0] * v[1][j][0] + v[1][j][1] * v[1][j][1]) + (v[1][j][2] * v[1][j][2] + v[1][j][3] * v[1][j][3]); }
        const float rs0 = 1.0f / sqrtf(wave_sum(s0) * (1.0f / D) + EPS), rs1 = 1.0f / sqrtf(wave_sum(s1) * (1.0f / D) + EPS);
        u32x2* o = (u32x2*)(H + (size_t)m * D) + lane;
#pragma unroll
        for (int j = 0; j < 8; ++j) { const f32x4 gg = gr[64 * j]; u32x2 w;
            w.x = cvt_pk_bf16(v[0][j][0] * rs0 * gg[0], v[0][j][1] * rs0 * gg[1]); w.y = cvt_pk_bf16(v[0][j][2] * rs0 * gg[2], v[0][j][3] * rs0 * gg[3]); o[64 * j] = w;
            w.x = cvt_pk_bf16(v[1][j][0] * rs1 * gg[0], v[1][j][1] * rs1 * gg[1]); w.y = cvt_pk_bf16(v[1][j][2] * rs1 * gg[2], v[1][j][3] * rs1 * gg[3]); o[512 + 64 * j] = w; }
    }
    if (blockIdx.x == 0 && tid < 64) ((unsigned*)(ws + OFF_CNT))[64 * tid] = 0u;
    const int G = gridDim.x, c = blockIdx.x;
    convert_matrix<false>(p.in[2], D, NIN, (bf16_t*)(ws + OFF_WINT), nullptr, lds, c, G);
}

constexpr int BP = 72;
constexpr int FP = 68;
constexpr int LRU_WAVE_LDS = 16 * BP * 2 + 2 * 16 * FP * 4;
constexpr int LRU_UNITS = NB * NH * 8;
__device__ __forceinline__ void lru_partA(const Params& p, LAS unsigned char* lds, int unit, float (&hloc)[64], float (&cumA)[64], float& Aex, float& hex, unsigned (&gpk)[32]) {
    const int tid = opaque_tid(), lane = tid & 63, wave = __builtin_amdgcn_readfirstlane(tid >> 6);
    const int bc = unit & 7, hd = (unit >> 3) & (NH - 1), b = unit >> 7;
    const int ch0 = hd * HD, tw0 = bc * 512 + wave * 64;
    LAS bf16_t* wab = (LAS bf16_t*)lds; LAS bf16_t* wxb = wab + 64 * BP;
    LAS float* totA = (LAS float*)(lds + 18432); LAS float* totH = totA + 512;
    LAS unsigned char* wl = lds + 22528 + wave * LRU_WAVE_LDS;
    LAS bf16_t* xcb = (LAS bf16_t*)wl; LAS float* us = (LAS float*)(wl + 16 * BP * 2); LAS float* as_ = us + 16 * FP;
    const bf16_t* P = (const bf16_t*)(p.ws + OFF_P);
    const float* cw = p.in[3]; const float* cb = p.in[4]; const float* wa = p.in[5]; const float* ba = p.in[6]; const float* wx = p.in[7]; const float* bx = p.in[8]; const float* lam = p.in[9];
    {
        const int e = tid * 8, i = e >> 6, j0 = e & 63;
        const float* s1 = wa + (size_t)hd * 4096 + e; const float* s2 = wx + (size_t)hd * 4096 + e;
        const f32x4 a0 = *(const f32x4*)s1, a1 = *(const f32x4*)(s1 + 4), x0 = *(const f32x4*)s2, x1 = *(const f32x4*)(s2 + 4);
        const float av[8] = {a0[0], a0[1], a0[2], a0[3], a1[0], a1[1], a1[2], a1[3]}; const float xv[8] = {x0[0], x0[1], x0[2], x0[3], x1[0], x1[1], x1[2], x1[3]};
#pragma unroll
        for (int q = 0; q < 8; ++q) { wab[(j0 + q) * BP + i] = (bf16_t)(cvt_pk_bf16(av[q], 0.f) & 0xffffu); wxb[(j0 + q) * BP + i] = (bf16_t)(cvt_pk_bf16(xv[q], 0.f) & 0xffffu); }
    }
    const int ctl = lane >> 3, c8 = (lane & 7) * 8;
    float w4[4][8], bb[8];
#pragma unroll
    for (int k = 0; k < 4; ++k) { const f32x4 q0 = *(const f32x4*)(cw + k * DL + ch0 + c8), q1 = *(const f32x4*)(cw + k * DL + ch0 + c8 + 4);
        w4[k][0] = q0[0]; w4[k][1] = q0[1]; w4[k][2] = q0[2]; w4[k][3] = q0[3]; w4[k][4] = q1[0]; w4[k][5] = q1[1]; w4[k][6] = q1[2]; w4[k][7] = q1[3]; }
    { const f32x4 q0 = *(const f32x4*)(cb + ch0 + c8), q1 = *(const f32x4*)(cb + ch0 + c8 + 4); bb[0] = q0[0]; bb[1] = q0[1]; bb[2] = q0[2]; bb[3] = q0[3]; bb[4] = q1[0]; bb[5] = q1[1]; bb[6] = q1[2]; bb[7] = q1[3]; }
    const int r16 = lane & 15, quad = lane >> 4;
    float bav[4], bxv[4], sp8[4];
#pragma unroll
    for (int ct = 0; ct < 4; ++ct) { const int ch = ch0 + 16 * ct + r16; bav[ct] = ba[ch]; bxv[ct] = bx[ch]; sp8[ct] = -8.0f * log1pf(__expf(-lam[ch])); }
    __syncthreads();
    float h = 0.f, A = 1.f;
#pragma unroll
    for (int sc = 0; sc < 4; ++sc) {
        const int ts0 = tw0 + 16 * sc;
#pragma unroll
        for (int ps = 0; ps < 2; ++ps) {
            const int tl = ps * 8 + ctl;
            float xc[8];
#pragma unroll
            for (int j = 0; j < 8; ++j) xc[j] = bb[j];
#pragma unroll
            for (int k = 0; k < 4; ++k) {
                const int tt = ts0 + tl - 3 + k;
                if (tt >= 0) { float xin[8]; unpack8(*(const u32x4*)(P + (size_t)(b * SEQ + tt) * NIN + PC_LX + ch0 + c8), xin);
#pragma unroll
                    for (int j = 0; j < 8; ++j) xc[j] += w4[k][j] * xin[j]; }
            }
            *(LAS f32x4*)(us + tl * FP + c8) = (f32x4){xc[0], xc[1], xc[2], xc[3]}; *(LAS f32x4*)(us + tl * FP + c8 + 4) = (f32x4){xc[4], xc[5], xc[6], xc[7]};
            *(LAS u32x4*)(xcb + tl * BP + c8) = pack8(xc);
        }
        LDS_WAIT();
        {
            bf16x8 af[2];
#pragma unroll
            for (int kk = 0; kk < 2; ++kk) af[kk] = *(const LAS bf16x8*)(xcb + r16 * BP + kk * 32 + quad * 8);
#pragma unroll
            for (int ct = 0; ct < 4; ++ct) {
                f32x4 ar = {0.f, 0.f, 0.f, 0.f}, ai = {0.f, 0.f, 0.f, 0.f};
#pragma unroll
                for (int kk = 0; kk < 2; ++kk) {
                    const bf16x8 b1 = *(const LAS bf16x8*)(wab + (16 * ct + r16) * BP + kk * 32 + quad * 8);
                    const bf16x8 b2 = *(const LAS bf16x8*)(wxb + (16 * ct + r16) * BP + kk * 32 + quad * 8);
                    ar = __builtin_amdgcn_mfma_f32_16x16x32_bf16(af[kk], b1, ar, 0, 0, 0);
                    ai = __builtin_amdgcn_mfma_f32_16x16x32_bf16(af[kk], b2, ai, 0, 0, 0);
                }
                const int j = 16 * ct + r16;
#pragma unroll
                for (int rg = 0; rg < 4; ++rg) {
                    const int t = quad * 4 + rg;
                    const float r = fast_sigmoid(ar[rg] + bav[ct]), ig = fast_sigmoid(ai[rg] + bxv[ct]);
                    const float a = __builtin_amdgcn_exp2f(1.4426950408889634f * (sp8[ct] * r)), mult = sqrtf(fmaxf(fmaf(-a, a, 1.0f), 0.f));
                    const float xc = us[t * FP + j];
                    us[t * FP + j] = mult * (ig * xc); as_[t * FP + j] = a;
                }
            }
        }
        LDS_WAIT();
#pragma unroll
        for (int s = 0; s < 16; ++s) { const float a = as_[s * FP + lane], uu = us[s * FP + lane]; h = a * h + uu; A *= a; hloc[sc * 16 + s] = h; cumA[sc * 16 + s] = A; }
        LDS_WAIT();
    }
    totA[wave * 64 + lane] = A; totH[wave * 64 + lane] = h;
    {
        const bf16_t* G = P + (size_t)(b * SEQ + tw0) * NIN + PC_LG + ch0 + lane;
#pragma unroll
        for (int s2 = 0; s2 < 32; ++s2) gpk[s2] = (unsigned)G[(size_t)(2 * s2) * NIN] | ((unsigned)G[(size_t)(2 * s2 + 1) * NIN] << 16);
    }
    __syncthreads();
    Aex = 1.f; hex = 0.f;
    for (int w = 0; w < wave; ++w) { const float a = totA[w * 64 + lane], hh = totH[w * 64 + lane]; hex = a * hex + hh; Aex *= a; }
    if (wave == 7) {
        const size_t o = (size_t)(b * 8 + bc) * DL + ch0 + lane;
        __hip_atomic_store((float*)(p.ws + OFF_LA) + o, Aex * A, __ATOMIC_RELAXED, __HIP_MEMORY_SCOPE_AGENT);
        __hip_atomic_store((float*)(p.ws + OFF_LH) + o, A * hex + h, __ATOMIC_RELAXED, __HIP_MEMORY_SCOPE_AGENT);
        asm volatile("s_waitcnt vmcnt(0)" ::: "memory");
        if (lane == 0) __hip_atomic_fetch_add((unsigned*)(p.ws + OFF_CNT) + 64 * (32 + b * NH + hd), 1u, __ATOMIC_RELAXED, __HIP_MEMORY_SCOPE_AGENT);
    }
}
__device__ __forceinline__ void lru_partB(const Params& p, int unit, const float (&hloc)[64], const float (&cumA)[64], float Aex, float hex, const unsigned (&gpk)[32]) {
    const int tid = opaque_tid(), lane = tid & 63, wave = __builtin_amdgcn_readfirstlane(tid >> 6);
    const int bc = unit & 7, hd = (unit >> 3) & (NH - 1), b = unit >> 7;
    const int ch0 = hd * HD, tw0 = bc * 512 + wave * 64;
    const float* LA = (const float*)(p.ws + OFF_LA); const float* LH = (const float*)(p.ws + OFF_LH);
    if (bc > 0) {
        if (tid == 0) { unsigned* cn = (unsigned*)(p.ws + OFF_CNT) + 64 * (32 + b * NH + hd);
            for (int spin = 0; spin < (1 << 24); ++spin) { if (__hip_atomic_load(cn, __ATOMIC_RELAXED, __HIP_MEMORY_SCOPE_AGENT) >= 8u) break; __builtin_amdgcn_s_sleep(1); } }
        __syncthreads();
    }
    float hin = 0.f;
    for (int c2 = 0; c2 < bc; ++c2) { const size_t o = (size_t)(b * 8 + c2) * DL + ch0 + lane;
        hin = __hip_atomic_load((float*)LA + o, __ATOMIC_RELAXED, __HIP_MEMORY_SCOPE_AGENT) * hin + __hip_atomic_load((float*)LH + o, __ATOMIC_RELAXED, __HIP_MEMORY_SCOPE_AGENT); }
    const float hw = Aex * hin + hex;
    bf16_t* O = (bf16_t*)(p.ws + OFF_HREG) + (size_t)(b * SEQ + tw0) * DL + ch0 + lane;
#pragma unroll
    for (int s = 0; s < 64; ++s) { const float gt = (s & 1) ? bf_hi(gpk[s >> 1]) : bf_lo(gpk[s >> 1]);
        O[(size_t)s * DL] = (bf16_t)(cvt_pk_bf16((hloc[s] + cumA[s] * hw) * gt, 0.f) & 0xffffu); }
}

__device__ __forceinline__ void sc_item_load(const bf16_t* P, int it, u32x4 (&cv)[3], u32x4 (&vv)[3], u32x4& bv) {
    const int row = it / (DS / 8), c8 = (it % (DS / 8)) * 8, t = row % SEQ;
#pragma unroll
    for (int k = 0; k < 3; ++k) {
        const int rr = (t - 2 + k >= 0) ? (row - 2 + k) : row;
        const bf16_t* pr = P + (size_t)rr * NIN + c8;
        cv[k] = *(const u32x4*)(pr + PC_SC); vv[k] = *(const u32x4*)(pr + PC_SV);
    }
    bv = *(const u32x4*)(P + (size_t)row * NIN + PC_SB + c8);
}
__device__ __forceinline__ void sc_item_finish(const float* cw, bf16_t* ASC, int it, const u32x4 (&cv)[3], const u32x4 (&vv)[3], const u32x4& bv) {
    const int row = it / (DS / 8), c8 = (it % (DS / 8)) * 8, t = row % SEQ;
    float acc[8] = {0.f, 0.f, 0.f, 0.f, 0.f, 0.f, 0.f, 0.f};
#pragma unroll
    for (int k = 0; k < 3; ++k) {
        float c[8], v[8]; unpack8(cv[k], c); unpack8(vv[k], v);
        const f32x4 w0 = *(const f32x4*)(cw + k * DS + c8), w1 = *(const f32x4*)(cw + k * DS + c8 + 4);
        const float wv[8] = {w0[0], w0[1], w0[2], w0[3], w1[0], w1[1], w1[2], w1[3]};
        const float msk = (t - 2 + k >= 0) ? 1.0f : 0.0f;
#pragma unroll
        for (int j = 0; j < 8; ++j) acc[j] += (msk * wv[j]) * (c[j] * v[j]);
    }
    float b[8]; unpack8(bv, b);
#pragma unroll
    for (int j = 0; j < 8; ++j) acc[j] *= b[j];
    *(u32x4*)(ASC + (size_t)row * DS + c8) = pack8(acc);
}
__device__ __forceinline__ void sc_phase(const Params& p) {
    const bf16_t* P = (const bf16_t*)(p.ws + OFF_P);
    bf16_t* ASC = (bf16_t*)(p.ws + OFF_HREG) + (size_t)MTOK * DL;
    const float* cw = p.in[11];
    const int nth = gridDim.x * 512, NIT = MTOK * (DS / 8);
    for (int it = blockIdx.x * 512 + opaque_tid(); it < NIT; it += 4 * nth) {
        u32x4 cv[4][3], vv[4][3], bv[4];
#pragma unroll
        for (int q = 0; q < 4; ++q) if (it + q * nth < NIT) sc_item_load(P, it + q * nth, cv[q], vv[q], bv[q]);
#pragma unroll
        for (int q = 0; q < 4; ++q) if (it + q * nth < NIT) sc_item_finish(cw, ASC, it + q * nth, cv[q], vv[q], bv[q]);
    }
}

__device__ __forceinline__ void final_norm_phase(const Params& p) {
    const int tid = opaque_tid(), lane = tid & 63, wave = tid >> 6;
    const int gw = blockIdx.x * 8 + wave, NGW = gridDim.x * 8;
    const float* g = p.in[18];
    for (int m = gw; m < MTOK; m += NGW) {
        f32x4* xr = (f32x4*)(p.out + (size_t)m * D) + lane; const f32x4* gr = (const f32x4*)g + lane;
        f32x4 v[8]; float s = 0.f;
#pragma unroll
        for (int j = 0; j < 8; ++j) { v[j] = xr[64 * j]; s += (v[j][0] * v[j][0] + v[j][1] * v[j][1]) + (v[j][2] * v[j][2] + v[j][3] * v[j][3]); }
        const float rstd = 1.0f / sqrtf(wave_sum(s) * (1.0f / D) + EPS);
#pragma unroll
        for (int j = 0; j < 8; ++j) { const f32x4 gg = gr[64 * j]; xr[64 * j] = (f32x4){v[j][0] * rstd * gg[0], v[j][1] * rstd * gg[1], v[j][2] * rstd * gg[2], v[j][3] * rstd * gg[3]}; }
    }
}

#define XB_TMO      128
#define XB_XCNT(j)  (256  + 64 * (j))
#define XB_XSUB(j)  (1280 + 64 * (j))
#define XB_XGEN(j)  (2304 + 64 * (j))
#define XB_TOP      3328
#define XB_TOPGEN   3392
#define XCD_BAR_WORDS 3456
#define XB_SPIN_CAP (1u << 18)

__device__ __forceinline__ unsigned xb_ld(unsigned* p)              { return __hip_atomic_load(p, __ATOMIC_RELAXED, __HIP_MEMORY_SCOPE_AGENT); }
__device__ __forceinline__ unsigned xb_add(unsigned* p, unsigned v) { return __hip_atomic_fetch_add(p, v, __ATOMIC_RELAXED, __HIP_MEMORY_SCOPE_AGENT); }
__device__ __forceinline__ unsigned xb_xcc_id() { return (unsigned)__builtin_amdgcn_s_getreg((3 << 11) | 20) & 0xFu; }
#define XB_SPIN(cond, bar) do { unsigned _sp = 0; while (cond) { __builtin_amdgcn_s_sleep(1); \
    if ((++_sp & 255u) == 0u) { if (xb_ld(&(bar)[XB_TMO])) break; if (_sp > XB_SPIN_CAP) { atomicAdd(&(bar)[XB_TMO], 1u); break; } } } } while (0)

struct XcdBarrier {
    unsigned* bar; unsigned x;
    volatile LAS unsigned* st;
};

__device__ __forceinline__ XcdBarrier xcd_barrier_post(unsigned* bar, volatile LAS unsigned* st) {
    XcdBarrier b; b.bar = bar; b.x = xb_xcc_id(); b.st = st;
    if (threadIdx.x == 0) (void)xb_add(&bar[XB_XCNT(b.x)], 1u);
    return b;
}
__device__ __forceinline__ void xcd_barrier_complete(unsigned* bar, unsigned x, unsigned& nloc, unsigned& nx) {
    const unsigned G = gridDim.x * gridDim.y * gridDim.z;
    unsigned sum, cnt, mine, sp = 0u;
    for (;;) {
        sum = 0u; cnt = 0u; mine = 0u;
#pragma unroll
        for (unsigned j = 0; j < 16; ++j) { const unsigned c = xb_ld(&bar[XB_XCNT(j)]); sum += c; cnt += (c > 0u) ? 1u : 0u; mine = (j == x) ? c : mine; }
        if (sum == G) break;
        __builtin_amdgcn_s_sleep(1);
        if ((++sp & 255u) == 0u) { if (xb_ld(&bar[XB_TMO])) break; if (sp > XB_SPIN_CAP) { atomicAdd(&bar[XB_TMO], 1u); break; } }
    }
    nloc = mine > 0u ? mine : 1u; nx = cnt > 0u ? cnt : 1u;
}

__device__ __forceinline__ void xcd_barrier(const XcdBarrier& b) {
    asm volatile("s_waitcnt vmcnt(0)" ::: "memory");
    __syncthreads();
    if (threadIdx.x == 0) {
        unsigned* bar = b.bar;
        __builtin_amdgcn_s_waitcnt(0);
        unsigned nloc = b.st[0], nx = b.st[1];
        if (nloc == 0u) { xcd_barrier_complete(bar, b.x, nloc, nx); b.st[0] = nloc; b.st[1] = nx; }
        const unsigned old = xb_add(&bar[XB_XSUB(b.x)], 1u);
        const unsigned gen = old / nloc;
        if (old + 1u == (gen + 1u) * nloc) {
            __builtin_amdgcn_fence(__ATOMIC_RELEASE, "agent");
            asm volatile("s_waitcnt vmcnt(0)" ::: "memory");
            const unsigned og = xb_add(&bar[XB_TOP], 1u);
            const unsigned tg = og / nx;
            if (og + 1u == (tg + 1u) * nx) xb_add(&bar[XB_TOPGEN], 1u);
            else XB_SPIN(xb_ld(&bar[XB_TOPGEN]) == tg, bar);
            __builtin_amdgcn_fence(__ATOMIC_ACQUIRE, "agent");
            xb_add(&bar[XB_XGEN(b.x)], 1u);
            asm volatile("s_waitcnt vmcnt(0)" ::: "memory");
        } else {
            XB_SPIN(xb_ld(&bar[XB_XGEN(b.x)]) == gen, bar);
            __builtin_amdgcn_fence(__ATOMIC_ACQUIRE, "agent");
            asm volatile("s_waitcnt vmcnt(0)" ::: "memory");
        }
    }
    __syncthreads();
}


__global__ void __launch_bounds__(512, 2) mega_fwd(Params p) {
    extern __shared__ __attribute__((aligned(16))) unsigned char lds_raw[];
    LAS unsigned char* lds = (LAS unsigned char*)lds_raw;
    cg::grid_group grid = cg::this_grid();
    unsigned char* ws = p.ws;
    const int G = gridDim.x, c = blockIdx.x;
    LAS unsigned* stw = (LAS unsigned*)(lds + LDS_BYTES - 16);
    if (threadIdx.x < 4) stw[threadIdx.x] = 0u;
    __syncthreads();
    const XcdBarrier xb = xcd_barrier_post((unsigned*)(ws + OFF_BAR), (volatile LAS unsigned*)stw);

    phase0(p, lds);
    if (G == 0) grid.sync();
    xcd_barrier(xb);
    {
        pg8::Gemm g{(const bf16_t*)(ws + OFF_HREG), (const bf16_t*)(ws + OFF_WINT), MTOK, NIN, D, nullptr, nullptr}; pg8::StaticOrder S; S.init(MTOK, NIN, G, c);
        EpiIn E{(bf16_t*)(ws + OFF_P)};
        pg8::gemm_phase<EpiIn, pg8::StaticOrder>(lds, g, S, E);
        const int rem = S.nwg % G;
        if (rem == 0 || c >= rem) {
            const int wk = rem ? c - rem : c, nwk = rem ? G - rem : G;
            convert_matrix<false, true>(p.in[10], DL, D, (bf16_t*)(ws + OFF_WLRU), nullptr, lds, wk, nwk);
            convert_matrix<false, true>(p.in[12], DS, D, (bf16_t*)(ws + OFF_WSC), nullptr, lds, wk, nwk);
            convert_matrix<false, true>(p.in[13], D, D, (bf16_t*)(ws + OFF_WO), nullptr, lds, wk, nwk);
            convert_matrix<true, true>(p.in[15], D, NUP, (bf16_t*)(ws + OFF_WUP), p.in[14], lds, wk, nwk);
        }
    }
    xcd_barrier(xb);
    sc_phase(p);
    {
        float hloc[64], cumA[64], Aex = 1.f, hex = 0.f; unsigned gpk[32];
        const bool has_unit = c < LRU_UNITS;
        if (has_unit) { lru_partA(p, lds, c, hloc, cumA, Aex, hex, gpk); lru_partB(p, c, hloc, cumA, Aex, hex, gpk); }
    }
    xcd_barrier(xb);
    {
        pg8::StaticOrder S; S.init(MTOK, D, G, c);
        pg8::Gemm g{(const bf16_t*)(ws + OFF_HREG), (const bf16_t*)(ws + OFF_WLRU), MTOK, D, DL, (const bf16_t*)(ws + OFF_HREG) + (size_t)MTOK * DL, (const bf16_t*)(ws + OFF_WSC)};
        EpiMix E{(const bf16_t*)(ws + OFF_P), (bf16_t*)(ws + OFF_MRG)};
        pg8::gemm_phase<EpiMix, pg8::StaticOrder, 2>(lds, g, S, E);
    }
    xcd_barrier(xb);
    {
        pg8::Gemm g{(const bf16_t*)(ws + OFF_MRG), (const bf16_t*)(ws + OFF_WO), MTOK, D, D, nullptr, nullptr}; pg8::StaticOrder S; S.init(MTOK, D, G, c);
        EpiO E{p.in[0], (bf16_t*)(ws + OFF_HREG), (float*)(ws + OFF_SQ)};
        pg8::gemm_phase<EpiO, pg8::StaticOrder>(lds, g, S, E);
    }
    xcd_barrier(xb);
    {
        pg8::Gemm g{(const bf16_t*)(ws + OFF_HREG), (const bf16_t*)(ws + OFF_WUP), MTOK, NUP, D, nullptr, nullptr}; pg8::StaticOrder S; S.init(MTOK, NUP, G, c);
        int last_pm = -1, epi_ui = 0;
        {
            LAS float* wl0 = (LAS float*)(lds + pg8::STAGE_BYTES) + 2048 + 256;
            Unit uu; const int t0 = opaque_tid();
            for (int i = 0; i < 6 && S.next(i, uu); ++i)
                if (t0 < 192) { const int k = t0 >> 6, q = t0 & 63, bj = q >> 5;
                    *(LAS f32x4*)(wl0 + 768 * i + k * 256 + 4 * q) = *(const f32x4*)(p.in[16] + k * NUP + bj * DFF + uu.pn * 128 + ((4 * q) & 127)); }
            __syncthreads();
        }
        EpiUpConv E{(const float*)(ws + OFF_SQ), (bf16_t*)(ws + OFF_FF), p.in[16], (float*)(ws + OFF_HALO), (LAS float*)(lds + pg8::STAGE_BYTES), &last_pm, &epi_ui};
        pg8::gemm_phase<EpiUpConv, pg8::StaticOrder>(lds, g, S, E);
        const int rem = S.nwg % G;
        if (rem == 0) convert_matrix<false, true>(p.in[17], DFF, D, (bf16_t*)(ws + OFF_WDN), nullptr, lds, c, G);
        else if (c >= rem) convert_matrix<false, true>(p.in[17], DFF, D, (bf16_t*)(ws + OFF_WDN), nullptr, lds, c - rem, G - rem);
    }
    xcd_barrier(xb);
    {
        pg8::Gemm g{(const bf16_t*)(ws + OFF_FF), (const bf16_t*)(ws + OFF_WDN), MTOK, D, DFF, nullptr, nullptr}; pg8::StaticOrder S; S.init(MTOK, D, G, c);
        { Unit u; for (int ui = 0; S.next(ui, u); ++ui) ff_fixup((const float*)(ws + OFF_HALO), p.in[16], (bf16_t*)(ws + OFF_FF), u.pm);
          asm volatile("s_waitcnt vmcnt(0)" ::: "memory"); __syncthreads(); }
        EpiDnNorm E{p.out, (const bf16_t*)(ws + OFF_HREG), p.in[18], (float*)(ws + OFF_SQ2), (unsigned*)(ws + OFF_CNT)};
        pg8::gemm_phase<EpiDnNorm, pg8::StaticOrder>(lds, g, S, E);
    }
}

extern "C" void kernel_launch(void* const* d_in, const int* in_sizes, int n_in, void* d_out, int out_size, void* d_ws, size_t ws_size, hipStream_t stream) {
    static int grid_blocks = 0;
    if (grid_blocks == 0) {
        if (n_in != 19 || out_size != MTOK * D || ws_size < WS_END) { fprintf(stderr, "kernel_launch: unexpected shapes (n_in %d out %d ws %zu, need %zu)\n", n_in, out_size, ws_size, (size_t)WS_END); grid_blocks = -1; return; }
        int dev = 0, cus = 0, per_cu = 0;
        (void)hipGetDevice(&dev);
        (void)hipDeviceGetAttribute(&cus, hipDeviceAttributeMultiprocessorCount, dev);
        (void)hipFuncSetAttribute((const void*)mega_fwd, hipFuncAttributeMaxDynamicSharedMemorySize, LDS_BYTES);
        (void)hipOccupancyMaxActiveBlocksPerMultiprocessor(&per_cu, (const void*)mega_fwd, 512, LDS_BYTES);
        if (per_cu < 1) { fprintf(stderr, "kernel_launch: occupancy query says %d blocks/CU\n", per_cu); per_cu = 1; }
        if (cus < LRU_UNITS) { fprintf(stderr, "kernel_launch: needs >= %d CUs (got %d)\n", LRU_UNITS, cus); grid_blocks = -1; return; }
        grid_blocks = cus;
    }
    if (grid_blocks < 0) return;
    Params p{};
    for (int i = 0; i < 19; ++i) p.in[i] = (const float*)d_in[i];
    p.out = (float*)d_out; p.ws = (unsigned char*)d_ws;
    (void)hipMemsetAsync((char*)d_ws + OFF_BAR, 0, XCD_BAR_WORDS * 4, stream);
    void* args[] = {&p};
    hipError_t e = hipLaunchCooperativeKernel((const void*)mega_fwd, dim3(grid_blocks), dim3(512), args, LDS_BYTES, stream);
    if (e != hipSuccess) fprintf(stderr, "cooperative launch failed: %s (grid %d)\n", hipGetErrorString(e), grid_blocks);
}
```

```cpp
#include <hip/hip_runtime.h>
#include <cstdio>

#ifndef NAIVE_KLOOP
#define NAIVE_KLOOP 0
#endif

#define LAS __attribute__((address_space(3)))
typedef unsigned short bf16_t;
typedef short bf16x8 __attribute__((ext_vector_type(8)));
typedef float f32x4 __attribute__((ext_vector_type(4)));
typedef float f32x2 __attribute__((ext_vector_type(2)));
typedef unsigned u32x4 __attribute__((ext_vector_type(4)));
typedef unsigned u32x2 __attribute__((ext_vector_type(2)));

constexpr int SEQ = 4096, NB = 2, MTOK = NB * SEQ;
constexpr int D = 2048, DL = 1024, DS = 1024, DFF = 5632, NUP = 2 * DFF, NIN = 2 * DL + 3 * DS + 2 * D;
constexpr int NH = 16, HD = 64;
constexpr float EPS = 1e-6f;
constexpr int PC_LX = 0, PC_LG = 1024, PC_SB = 2048, PC_SC = 3072, PC_SV = 4096, PC_GL = 5120, PC_GS = 7168;
constexpr int LNCH = 8;

constexpr size_t OFF_WINT = 0;
constexpr size_t OFF_WLRU = OFF_WINT + (size_t)NIN * D * 2;
constexpr size_t OFF_WSC  = OFF_WLRU + (size_t)D * DL * 2;
constexpr size_t OFF_WO   = OFF_WSC + (size_t)D * DS * 2;
constexpr size_t OFF_HREG = OFF_WO + (size_t)D * D * 2;
constexpr size_t OFF_WUP  = (size_t)MTOK * DFF * 2;
constexpr size_t OFF_WDN  = OFF_WUP + (size_t)NUP * D * 2;
constexpr size_t OFF_P    = OFF_WDN + (size_t)D * DFF * 2;
constexpr size_t OFF_MRG  = OFF_P + (size_t)MTOK * NIN * 2;
constexpr size_t OFF_FF   = OFF_P;
constexpr size_t OFF_SQ   = OFF_MRG + (size_t)MTOK * D * 2;
constexpr size_t OFF_LA   = OFF_SQ + (size_t)MTOK * 32 * 4;
constexpr size_t OFF_LH   = OFF_LA + (size_t)NB * LNCH * DL * 4;
constexpr size_t OFF_HALO = OFF_LH + (size_t)NB * LNCH * DL * 4;
constexpr size_t OFF_SQ2  = OFF_HALO + (size_t)(MTOK / 256) * 4 * NUP * 4;
constexpr size_t OFF_CNT  = OFF_SQ2 + (size_t)(MTOK / 256) * 8 * 256 * 4;
constexpr size_t OFF_BAR  = OFF_CNT + (size_t)64 * 256;
constexpr size_t WS_END   = OFF_BAR + 3456 * 4;
static_assert(OFF_HREG + (size_t)MTOK * D * 2 <= OFF_WUP, "ws overlap");

constexpr int LDS_BYTES = 160 * 1024;

struct Params { const float* in[19]; float* out; unsigned char* ws; };

__device__ __forceinline__ unsigned cvt_pk_bf16(float lo, float hi) { unsigned r; asm volatile("v_cvt_pk_bf16_f32 %0, %1, %2" : "=v"(r) : "v"(lo), "v"(hi)); return r; }
__device__ __forceinline__ float bf_lo(unsigned w) { return __uint_as_float(w << 16); }
__device__ __forceinline__ float bf_hi(unsigned w) { return __uint_as_float(w & 0xffff0000u); }
__device__ __forceinline__ void unpack8(const u32x4 w, float (&f)[8]) {
    f[0] = bf_lo(w.x); f[1] = bf_hi(w.x); f[2] = bf_lo(w.y); f[3] = bf_hi(w.y); f[4] = bf_lo(w.z); f[5] = bf_hi(w.z); f[6] = bf_lo(w.w); f[7] = bf_hi(w.w);
}
__device__ __forceinline__ u32x4 pack8(const float (&f)[8]) { u32x4 o; o.x = cvt_pk_bf16(f[0], f[1]); o.y = cvt_pk_bf16(f[2], f[3]); o.z = cvt_pk_bf16(f[4], f[5]); o.w = cvt_pk_bf16(f[6], f[7]); return o; }
__device__ __forceinline__ float fast_sigmoid(float x) { return __builtin_amdgcn_rcpf(1.0f + __builtin_amdgcn_exp2f(-1.4426950408889634f * x)); }
__device__ __forceinline__ float gelu_tanh(float x) { const float u = 1.5957691216057308f * (x + 0.044715f * x * x * x); return x * fast_sigmoid(u); }
__device__ __forceinline__ float wave_sum(float v) {
#pragma unroll
    for (int o = 1; o < 64; o <<= 1) v += __shfl_xor(v, o);
    return v;
}
#define LDS_WAIT() asm volatile("s_waitcnt lgkmcnt(0)" ::: "memory")
__device__ __forceinline__ __amdgpu_buffer_rsrc_t wt_rsrc(void* base, size_t bytes) { return __builtin_amdgcn_make_buffer_rsrc(base, 0, (int)bytes, 0x00020000); }
__device__ __forceinline__ void store16_wt(__amdgpu_buffer_rsrc_t r, size_t byte_off, u32x4 v) { __builtin_amdgcn_raw_buffer_store_b128(v, r, (unsigned)byte_off, 0, 16); }
__device__ __forceinline__ int x1b_phys_row(int r) { const int s = r & 63; return (r & ~63) + 16 * (s & 3) + (s >> 2); }
__device__ __forceinline__ int opaque_tid() { int t = threadIdx.x; asm volatile("" : "+v"(t)); return t; }

namespace pg8 {
constexpr int BM = 256, BK = 64, HALF = 128, HTB = HALF * BK * 2, STAGE_BYTES = 8 * HTB, NXCD = 8, WGM = 8;
__host__ __device__ __forceinline__ int lds_byte(int r, int c) { const int st = (r >> 4) * 2 + (c >> 5), rr = r & 15, cc = c & 31, ob = rr * 64 + cc * 2; return st * 1024 + (ob ^ (((ob >> 9) & 1) << 5)); }
__host__ __device__ __forceinline__ void stage_rc(int b, int& R, int& C) { const int st = b / 1024, sb = b % 1024, swz = sb ^ (((sb >> 9) & 1) << 5); R = (st >> 1) * 16 + swz / 64; C = (st & 1) * 32 + (swz % 64) / 2; }
__host__ __device__ __forceinline__ int perm32(int rho) { const int n = rho >> 4, i = rho & 15; return 8 * (i >> 2) + 4 * n + (i & 3); }

struct Unit { int pm, pn; };
struct Gemm { const bf16_t* A; const bf16_t* Bt; int M, N, K; const bf16_t* A2; const bf16_t* Bt2; };

struct StaticOrder {
    int nM, nN, nwg, G, c;
    __host__ __device__ void init(int M, int N, int G_, int c_) { nM = M / BM; nN = N / BM; nwg = nM * nN; G = G_; c = c_; }
    __host__ __device__ bool next(int i, Unit& u) const {
        const long L = (long)i * G + c; if (L >= nwg) return false;
        int wgid = (int)L; { const int q = nwg / NXCD, r = nwg % NXCD, xcd = wgid % NXCD, off = wgid / NXCD; wgid = (xcd < r ? xcd * (q + 1) : r * (q + 1) + (xcd - r) * q) + off; }
        const int nig = WGM * nN, gid = wgid / nig, fm = gid * WGM, gsz = (nM - fm) < WGM ? (nM - fm) : WGM;
        u.pm = fm + ((wgid % nig) % gsz); u.pn = (wgid % nig) / gsz; return true;
    }
    __device__ __forceinline__ void a_ready(const Unit&) const {}
    __device__ __forceinline__ void done(const Unit&) const {}
};

#if !NAIVE_KLOOP
template <class Epi, class Sched, int NSEG = 1>
__device__ __forceinline__ void gemm_phase(LAS unsigned char* lds, const Gemm g, const Sched& S, const Epi& E) {
    const int tid = opaque_tid(), wid = __builtin_amdgcn_readfirstlane(tid >> 6), lane = tid & 63, wr = wid >> 2, wc = wid & 3, fr = lane & 15, fq = lane >> 4;
    const int K = g.K, nt = K / BK;
    unsigned voffA[2], voffB[2];
#pragma unroll
    for (int i = 0; i < 2; ++i) { int R, C; stage_rc(tid * 16 + i * 8192, R, C); const int Rb = Epi::PERM ? ((R & ~31) + perm32(R & 31)) : R;
        voffA[i] = (unsigned)(R * K + C) * 2u; voffB[i] = (unsigned)(Rb * K + C) * 2u; }
    const size_t kstep = (size_t)(BK * 2);
    const size_t hstep = (size_t)HALF * K * 2;
    const size_t tstep = 2 * hstep;
    const unsigned ldsw = (unsigned)wid * 1024u;
    const int aoff = lds_byte(wr * 64 + fr, fq * 8), boff = lds_byte(wc * 32 + fr, fq * 8);
#define PG8_SA(b, h) (((b) * 2 + (h)) * HTB)
#define PG8_SB(b, h) ((4 + (b) * 2 + (h)) * HTB)
#define PG8_STAGE(bufoff, gbase, voff) do { _Pragma("unroll") for (int _i = 0; _i < 2; ++_i) \
        __builtin_amdgcn_global_load_lds((const unsigned*)((const char*)(gbase) + (voff)[_i]), (LAS unsigned*)(lds + (bufoff) + ldsw + _i * 8192), 16, 0, 0); } while (0)
#define PG8_LDA(dst, b, h) do { _Pragma("unroll") for (int m = 0; m < 4; ++m) _Pragma("unroll") for (int k = 0; k < 2; ++k) dst[m][k] = *(const LAS bf16x8*)(lds + PG8_SA(b, h) + aoff + m * 2048 + k * 1024); } while (0)
#define PG8_LDB(dst, b, h) do { _Pragma("unroll") for (int n = 0; n < 2; ++n) _Pragma("unroll") for (int k = 0; k < 2; ++k) dst[n][k] = *(const LAS bf16x8*)(lds + PG8_SB(b, h) + boff + n * 2048 + k * 1024); } while (0)
#define PG8_MMA(ai, bj, At, Bt) do { __builtin_amdgcn_s_setprio(1); _Pragma("unroll") for (int m = 0; m < 4; ++m) _Pragma("unroll") for (int n = 0; n < 2; ++n) _Pragma("unroll") for (int k = 0; k < 2; ++k) \
        acc[ai][bj][m][n] = __builtin_amdgcn_mfma_f32_16x16x32_bf16(Bt[n][k], At[m][k], acc[ai][bj][m][n], 0, 0, 0); __builtin_amdgcn_s_setprio(0); } while (0)
#define PG8_WAIT_V(n) asm volatile("s_waitcnt vmcnt(" #n ")" ::: "memory")
#define PG8_WAIT_L(n) asm volatile("s_waitcnt lgkmcnt(" #n ")" ::: "memory")
#define PG8_BAR __builtin_amdgcn_s_barrier()
#define PG8_SCHED __builtin_amdgcn_sched_barrier(0)
    Unit cur, nxt; int ui = 0;
    if (!S.next(0, cur)) return;
    f32x4 acc[2][2][4][2];
#pragma unroll
    for (int a = 0; a < 2; ++a)
#pragma unroll
        for (int b = 0; b < 2; ++b)
#pragma unroll
            for (int m = 0; m < 4; ++m)
#pragma unroll
                for (int n = 0; n < 2; ++n) acc[a][b][m][n] = (f32x4){0.f, 0.f, 0.f, 0.f};
    bf16x8 At[4][2], B0[2][2], B1[2][2];
    const char* cA = (const char*)g.A + (size_t)cur.pm * tstep; const char* cB = (const char*)g.Bt + (size_t)cur.pn * tstep;
    S.a_ready(cur);
    PG8_STAGE(PG8_SB(0, 0), cB, voffB); PG8_STAGE(PG8_SA(0, 0), cA, voffA); PG8_STAGE(PG8_SB(0, 1), cB + hstep, voffB); PG8_STAGE(PG8_SA(0, 1), cA + hstep, voffA);
    if (wr == 1) PG8_BAR;
    PG8_WAIT_V(4); PG8_BAR;
    PG8_STAGE(PG8_SB(1, 0), cB + kstep, voffB); PG8_STAGE(PG8_SA(1, 0), cA + kstep, voffA); PG8_STAGE(PG8_SB(1, 1), cB + hstep + kstep, voffB);
    PG8_WAIT_V(6); PG8_BAR;
#define PG8_KLOOP(KA_, KB_, KNA_, KNB_) \
        for (int t = 0; t < nt; t += 2) { \
            const bool last = (t == nt - 2); \
            const char* a1 = KA_ + (size_t)(t + 1) * kstep; \
            const char* a2 = last ? KNA_ : KA_ + (size_t)(t + 2) * kstep; const char* b2 = last ? KNB_ : KB_ + (size_t)(t + 2) * kstep; \
            const char* a3 = a2 + kstep; const char* b3 = b2 + kstep; \
            PG8_LDB(B0, 0, 0); PG8_SCHED; PG8_LDA(At, 0, 0); PG8_STAGE(PG8_SA(1, 1), a1 + hstep, voffA); \
            PG8_WAIT_L(8); PG8_BAR; PG8_WAIT_L(0); PG8_MMA(0, 0, At, B0); PG8_BAR; PG8_SCHED; \
            PG8_LDB(B1, 0, 1); PG8_STAGE(PG8_SB(0, 0), b2, voffB); \
            PG8_BAR; PG8_WAIT_L(0); PG8_MMA(0, 1, At, B1); PG8_BAR; \
            PG8_LDA(At, 0, 1); PG8_STAGE(PG8_SA(0, 0), a2, voffA); \
            PG8_BAR; PG8_WAIT_L(0); PG8_MMA(1, 0, At, B0); PG8_BAR; PG8_SCHED; \
            PG8_STAGE(PG8_SB(0, 1), b2 + hstep, voffB); \
            PG8_WAIT_V(6); PG8_BAR; PG8_MMA(1, 1, At, B1); PG8_BAR; \
            PG8_LDB(B0, 1, 0); PG8_SCHED; PG8_LDA(At, 1, 0); PG8_STAGE(PG8_SA(0, 1), a2 + hstep, voffA); \
            PG8_WAIT_L(8); PG8_BAR; PG8_WAIT_L(0); PG8_MMA(0, 0, At, B0); PG8_BAR; PG8_SCHED; \
            PG8_LDB(B1, 1, 1); PG8_STAGE(PG8_SB(1, 0), b3, voffB); \
            PG8_BAR; PG8_WAIT_L(0); PG8_MMA(0, 1, At, B1); PG8_BAR; \
            PG8_LDA(At, 1, 1); PG8_STAGE(PG8_SA(1, 0), a3, voffA); \
            PG8_BAR; PG8_WAIT_L(0); PG8_MMA(1, 0, At, B0); PG8_BAR; PG8_SCHED; \
            PG8_STAGE(PG8_SB(1, 1), b3 + hstep, voffB); \
            PG8_WAIT_V(6); PG8_BAR; PG8_MMA(1, 1, At, B1); PG8_BAR; \
        }
    for (;;) {
        const bool has_next = S.next(ui + 1, nxt);
        if constexpr (NSEG == 2) {
            const char* cA2 = (const char*)g.A2 + (size_t)cur.pm * tstep; const char* cB2 = (const char*)g.Bt2 + (size_t)cur.pn * tstep;
            PG8_KLOOP(cA, cB, cA2, cB2)
            { const int t2 = opaque_tid(), w2 = __builtin_amdgcn_readfirstlane(t2 >> 6), l2 = t2 & 63; E.mid(acc, cur, w2 >> 2, w2 & 3, l2 & 15, l2 >> 4); }
            const char* nA = has_next ? (const char*)g.A + (size_t)nxt.pm * tstep : cA2; const char* nB = has_next ? (const char*)g.Bt + (size_t)nxt.pn * tstep : cB2;
            PG8_KLOOP(cA2, cB2, nA, nB)
            cA = nA; cB = nB;
        } else {
            const char* nA = has_next ? (const char*)g.A + (size_t)nxt.pm * tstep : cA; const char* nB = has_next ? (const char*)g.Bt + (size_t)nxt.pn * tstep : cB;
            PG8_KLOOP(cA, cB, nA, nB)
            cA = nA; cB = nB;
        }
        if constexpr (!Epi::AFTER_DRAIN) { const int t2 = opaque_tid(), w2 = __builtin_amdgcn_readfirstlane(t2 >> 6), l2 = t2 & 63; E(acc, cur, w2 >> 2, w2 & 3, l2 & 15, l2 >> 4); }
        S.done(cur);
        if (!has_next) break;
#pragma unroll
        for (int a = 0; a < 2; ++a)
#pragma unroll
            for (int b = 0; b < 2; ++b)
#pragma unroll
                for (int m = 0; m < 4; ++m)
#pragma unroll
                    for (int n = 0; n < 2; ++n) acc[a][b][m][n] = (f32x4){0.f, 0.f, 0.f, 0.f};
        cur = nxt; ++ui;
    }
    PG8_WAIT_V(0);
    if (wr == 0) PG8_BAR;
    PG8_BAR;
    if constexpr (Epi::AFTER_DRAIN) E.fused(acc, cur, lds);
#undef PG8_KLOOP
#undef PG8_SA
#undef PG8_SB
#undef PG8_STAGE
#undef PG8_LDA
#undef PG8_LDB
#undef PG8_MMA
#undef PG8_WAIT_V
#undef PG8_WAIT_L
#undef PG8_BAR
#undef PG8_SCHED
}
#else
template <class Epi, class Sched, int NSEG = 1>
__device__ __forceinline__ void gemm_phase(LAS unsigned char* lds, const Gemm g, const Sched& S, const Epi& E) {
    const int tid = threadIdx.x, wid = tid >> 6, lane = tid & 63, wr = wid >> 2, wc = wid & 3, fr = lane & 15, fq = lane >> 4;
    const int K = g.K;
    Unit cur;
    for (int ui = 0; S.next(ui, cur); ++ui) {
        f32x4 acc[2][2][4][2];
#pragma unroll
        for (int a = 0; a < 2; ++a)
#pragma unroll
            for (int b = 0; b < 2; ++b)
#pragma unroll
                for (int m = 0; m < 4; ++m)
#pragma unroll
                    for (int n = 0; n < 2; ++n) acc[a][b][m][n] = (f32x4){0.f, 0.f, 0.f, 0.f};
        const bf16_t* Ab = g.A + (size_t)(cur.pm * BM + wr * 64 + fr) * K;
        const bf16_t* Bb = g.Bt + (size_t)(cur.pn * BM + wc * 32 + 8 * fq) * K;
        for (int k0 = 0; k0 < K; k0 += 2) {
            float a0[2][4], a1[2][4];
#pragma unroll
            for (int ai = 0; ai < 2; ++ai)
#pragma unroll
                for (int m = 0; m < 4; ++m) { const unsigned w = *(const unsigned*)(Ab + (size_t)(ai * HALF + m * 16) * K + k0); a0[ai][m] = bf_lo(w); a1[ai][m] = bf_hi(w); }
#pragma unroll
            for (int bj = 0; bj < 2; ++bj)
#pragma unroll
                for (int n = 0; n < 2; ++n)
#pragma unroll
                    for (int j = 0; j < 4; ++j) { const unsigned w = *(const unsigned*)(Bb + (size_t)(bj * HALF + 4 * n + j) * K + k0); const float b0 = bf_lo(w), b1 = bf_hi(w);
#pragma unroll
                        for (int ai = 0; ai < 2; ++ai)
#pragma unroll
                            for (int m = 0; m < 4; ++m) acc[ai][bj][m][n][j] += a0[ai][m] * b0 + a1[ai][m] * b1; }
        }
        if constexpr (Epi::AFTER_DRAIN) { __syncthreads(); E.fused(acc, cur, lds); } else E(acc, cur, wr, wc, fr, fq);
    }
    __syncthreads();
}
#endif
}
using pg8::Unit;

#define EPI_ROWS_BEGIN \
    const int row0 = u.pm * 256 + wr * 64 + fr, col0 = u.pn * 256 + wc * 32 + 8 * fq; \
    _Pragma("unroll") for (int ai = 0; ai < 2; ++ai) _Pragma("unroll") for (int m = 0; m < 4; ++m) { const int row = row0 + ai * 128 + m * 16;
#define EPI_COLS_BEGIN \
    _Pragma("unroll") for (int bj = 0; bj < 2; ++bj) { const int col = col0 + bj * 128; const f32x4 v0 = acc[ai][bj][m][0], v1 = acc[ai][bj][m][1]; \
        float v[8] = {v0[0], v0[1], v0[2], v0[3], v1[0], v1[1], v1[2], v1[3]};
#define EPI_END } }

struct EpiIn {
    static constexpr bool PERM = true, AFTER_DRAIN = false;
    bf16_t* P;
    __device__ __forceinline__ void operator()(f32x4 (&acc)[2][2][4][2], const Unit& u, int wr, int wc, int fr, int fq) const {
        const int mode = (u.pn < 4) ? 0 : (u.pn < 8) ? 1 : (u.pn < 20) ? 0 : 2;
        const __amdgpu_buffer_rsrc_t rs = wt_rsrc(P, (size_t)MTOK * NIN * 2);
        EPI_ROWS_BEGIN
        EPI_COLS_BEGIN
            if (mode == 1) {
#pragma unroll
                for (int j = 0; j < 8; ++j) v[j] = gelu_tanh(v[j]);
            } else if (mode == 2) {
#pragma unroll
                for (int j = 0; j < 8; ++j) v[j] = fast_sigmoid(v[j]);
            }
            store16_wt(rs, ((size_t)row * NIN + col) * 2, pack8(v));
        EPI_END
    }
};
struct EpiMix {
    static constexpr bool PERM = true, AFTER_DRAIN = false;
    const bf16_t* P; bf16_t* MRG;
    __device__ __forceinline__ void mid(f32x4 (&acc)[2][2][4][2], const Unit& u, int wr, int wc, int fr, int fq) const {
        const int row0 = u.pm * 256 + wr * 64 + fr, col0 = u.pn * 256 + wc * 32 + 8 * fq;
#pragma unroll
        for (int ai = 0; ai < 2; ++ai)
#pragma unroll
            for (int m = 0; m < 4; ++m) { const int row = row0 + ai * 128 + m * 16;
#pragma unroll
                for (int bj = 0; bj < 2; ++bj) { const int col = col0 + bj * 128;
                    float gl[8], gs[8]; unpack8(*(const u32x4*)(P + (size_t)row * NIN + PC_GL + col), gl); unpack8(*(const u32x4*)(P + (size_t)row * NIN + PC_GS + col), gs);
#pragma unroll
                    for (int j = 0; j < 8; ++j) { const float rt = gl[j] * __builtin_amdgcn_rcpf(fmaxf(gs[j], 1e-30f)); if (j < 4) acc[ai][bj][m][0][j] *= rt; else acc[ai][bj][m][1][j - 4] *= rt; } }
                if (m == 3) asm volatile("" ::: "memory"); }
    }
    __device__ __forceinline__ void operator()(f32x4 (&acc)[2][2][4][2], const Unit& u, int wr, int wc, int fr, int fq) const {
        const int row0 = u.pm * 256 + wr * 64 + fr, col0 = u.pn * 256 + wc * 32 + 8 * fq;
        const __amdgpu_buffer_rsrc_t rs = wt_rsrc(MRG, (size_t)MTOK * D * 2);
#pragma unroll
        for (int ai = 0; ai < 2; ++ai) {
            u32x4 gr[4][2];
#pragma unroll
            for (int m = 0; m < 4; ++m)
#pragma unroll
                for (int bj = 0; bj < 2; ++bj) gr[m][bj] = *(const u32x4*)(P + (size_t)(row0 + ai * 128 + m * 16) * NIN + PC_GS + col0 + bj * 128);
#pragma unroll
            for (int m = 0; m < 4; ++m)
#pragma unroll
                for (int bj = 0; bj < 2; ++bj) asm volatile("" : "+v"(gr[m][bj]));
#pragma unroll
            for (int m = 0; m < 4; ++m) { const int row = row0 + ai * 128 + m * 16;
#pragma unroll
                for (int bj = 0; bj < 2; ++bj) { const int col = col0 + bj * 128; const f32x4 v0 = acc[ai][bj][m][0], v1 = acc[ai][bj][m][1];
                    float v[8] = {v0[0], v0[1], v0[2], v0[3], v1[0], v1[1], v1[2], v1[3]};
                    float gs[8]; unpack8(gr[m][bj], gs);
#pragma unroll
                    for (int j = 0; j < 8; ++j) v[j] *= fmaxf(gs[j], 1e-30f);
                    store16_wt(rs, ((size_t)row * D + col) * 2, pack8(v)); } }
            asm volatile("" ::: "memory");
        }
    }
};
struct EpiO {
    static constexpr bool PERM = true, AFTER_DRAIN = false;
    const float* X; bf16_t* X1B; float* SQ;
    __device__ __forceinline__ void operator()(f32x4 (&acc)[2][2][4][2], const Unit& u, int wr, int wc, int fr, int fq) const {
        const int row0 = u.pm * 256 + wr * 64 + fr, col0 = u.pn * 256 + wc * 32 + 8 * fq;
        const __amdgpu_buffer_rsrc_t rs = wt_rsrc(X1B, (size_t)MTOK * D * 2);
#pragma unroll
        for (int ai = 0; ai < 2; ++ai)
#pragma unroll
            for (int mp = 0; mp < 2; ++mp) {
                f32x4 xr[2][2][2];
#pragma unroll
                for (int mm = 0; mm < 2; ++mm)
#pragma unroll
                    for (int bj = 0; bj < 2; ++bj) { const float* xp = X + (size_t)(row0 + ai * 128 + (2 * mp + mm) * 16) * D + col0 + bj * 128; xr[mm][bj][0] = *(const f32x4*)xp; xr[mm][bj][1] = *(const f32x4*)(xp + 4); }
#pragma unroll
                for (int mm = 0; mm < 2; ++mm)
#pragma unroll
                    for (int bj = 0; bj < 2; ++bj) asm volatile("" : "+v"(xr[mm][bj][0]), "+v"(xr[mm][bj][1]));
#pragma unroll
                for (int mm = 0; mm < 2; ++mm) { const int m = 2 * mp + mm, row = row0 + ai * 128 + m * 16; float ss = 0.f;
#pragma unroll
                    for (int bj = 0; bj < 2; ++bj) { const int col = col0 + bj * 128;
                        const f32x4 a = acc[ai][bj][m][0] + xr[mm][bj][0], b = acc[ai][bj][m][1] + xr[mm][bj][1];
                        float v[8] = {a[0], a[1], a[2], a[3], b[0], b[1], b[2], b[3]};
#pragma unroll
                        for (int j = 0; j < 8; ++j) ss += v[j] * v[j];
                        store16_wt(rs, ((size_t)x1b_phys_row(row) * D + col) * 2, pack8(v)); }
                    ss += __shfl_xor(ss, 16); ss += __shfl_xor(ss, 32);
                    if (fq == 0) SQ[(size_t)row * 32 + u.pn * 4 + wc] = ss; }
                asm volatile("" ::: "memory");
            }
    }
};
__device__ __forceinline__ float dpp_shr1(float old, float src) { return __int_as_float(__builtin_amdgcn_update_dpp(__float_as_int(old), __float_as_int(src), 0x111, 0xf, 0xf, false)); }
__device__ __forceinline__ float dpp_shr2(float old, float src) { return __int_as_float(__builtin_amdgcn_update_dpp(__float_as_int(old), __float_as_int(src), 0x112, 0xf, 0xf, false)); }
__device__ __forceinline__ float dpp_shr1z(float src) { return __int_as_float(__builtin_amdgcn_update_dpp(0, __float_as_int(src), 0x111, 0xf, 0xf, true)); }
__device__ __forceinline__ float dpp_shr2z(float src) { return __int_as_float(__builtin_amdgcn_update_dpp(0, __float_as_int(src), 0x112, 0xf, 0xf, true)); }
__device__ __forceinline__ float dpp_ror1(float src) { return __int_as_float(__builtin_amdgcn_update_dpp(0, __float_as_int(src), 0x121, 0xf, 0xf, false)); }
__device__ __forceinline__ float dpp_ror2(float src) { return __int_as_float(__builtin_amdgcn_update_dpp(0, __float_as_int(src), 0x122, 0xf, 0xf, false)); }
struct EpiUpConv {
    static constexpr bool PERM = true, AFTER_DRAIN = false;
    const float* SQ; bf16_t* FF; const float* cw; float* HALO; LAS float* hal; int* last_pm; int* ui;
    __device__ __forceinline__ void operator()(f32x4 (&acc)[2][2][4][2], const Unit& u, int wr, int wc, int fr, int fq) const {
        const int tid = opaque_tid();
        LAS float* rsl = hal + 2048; LAS float* wl = rsl + 256 + 768 * (*ui);
        const int row0 = u.pm * 256 + wr * 64 + fr;
        const int ch0 = u.pn * 128 + wc * 32 + 8 * fq;
        if (tid < 256 && u.pm != *last_pm) {
            const f32x4* sp = (const f32x4*)(SQ + (size_t)(u.pm * 256 + tid) * 32);
            f32x4 t = sp[0];
#pragma unroll
            for (int i = 1; i < 8; ++i) t += sp[i];
            rsl[tid] = 1.0f / sqrtf(((t[0] + t[1]) + (t[2] + t[3])) * (1.0f / D) + EPS);
        }
        if (fr == 15) {
#pragma unroll
            for (int ai = 0; ai < 2; ++ai) { LAS float* h = hal + ((((2 * ai + wr) * 4 + wc) * 4 + fq) * 2) * 16;
#pragma unroll
                for (int bj = 0; bj < 2; ++bj)
#pragma unroll
                    for (int n = 0; n < 2; ++n) { *(LAS f32x4*)(h + bj * 8 + n * 4) = acc[ai][bj][2][n]; *(LAS f32x4*)(h + 16 + bj * 8 + n * 4) = acc[ai][bj][3][n]; } }
        }
        asm volatile("s_waitcnt lgkmcnt(0)" ::: "memory"); __builtin_amdgcn_s_barrier(); __builtin_amdgcn_s_barrier(); asm volatile("" ::: "memory");
        float r[2][4], rp62[2], rp63[2];
#pragma unroll
        for (int ai = 0; ai < 2; ++ai) {
            const int strip = 2 * ai + wr;
            const f32x4 rr = *(const LAS f32x4*)(rsl + 64 * strip + 4 * fr);
            r[ai][0] = rr[0]; r[ai][1] = rr[1]; r[ai][2] = rr[2]; r[ai][3] = rr[3];
            rp62[ai] = 0.f; rp63[ai] = 0.f;
            if (strip > 0) { rp62[ai] = rsl[64 * strip - 2]; rp63[ai] = rsl[64 * strip - 1]; }
        }
        if (wr == 0 && fr == 0) {
#pragma unroll
            for (int m = 0; m < 2; ++m) { float* g = HALO + (size_t)(u.pm * 4 + m) * NUP + u.pn * 256 + wc * 32 + 8 * fq;
#pragma unroll
                for (int bj = 0; bj < 2; ++bj) { *(f32x4*)(g + bj * 128) = acc[0][bj][m][0] * r[0][m]; *(f32x4*)(g + bj * 128 + 4) = acc[0][bj][m][1] * r[0][m]; } } }
        if (wr == 1 && fr == 15) {
#pragma unroll
            for (int m = 2; m < 4; ++m) { float* g = HALO + (size_t)(u.pm * 4 + m) * NUP + u.pn * 256 + wc * 32 + 8 * fq;
#pragma unroll
                for (int bj = 0; bj < 2; ++bj) { *(f32x4*)(g + bj * 128) = acc[1][bj][m][0] * r[1][m]; *(f32x4*)(g + bj * 128 + 4) = acc[1][bj][m][1] * r[1][m]; } } }
        asm volatile("" ::: "memory");
        const __amdgpu_buffer_rsrc_t ffrs = wt_rsrc(FF, (size_t)MTOK * DFF * 2);
#pragma unroll
        for (int ai = 0; ai < 2; ++ai) {
            const int strip = 2 * ai + wr;
#pragma unroll
            for (int bj = 0; bj < 2; ++bj)
#pragma unroll
                for (int n = 0; n < 2; ++n) {
                    const int tcol = bj * 128 + wc * 32 + 8 * fq + 4 * n;
                    const f32x4 w0 = *(const LAS f32x4*)(wl + tcol), w1 = *(const LAS f32x4*)(wl + 256 + tcol), w2 = *(const LAS f32x4*)(wl + 512 + tcol);
                    f32x4 q62 = {0.f, 0.f, 0.f, 0.f}, q63 = {0.f, 0.f, 0.f, 0.f};
                    if (strip > 0) { const LAS float* h = hal + ((((strip - 1) * 4 + wc) * 4 + fq) * 2) * 16 + bj * 8 + n * 4;
                        q62 = *(const LAS f32x4*)h * rp62[ai]; q63 = *(const LAS f32x4*)(h + 16) * rp63[ai]; }
                    LDS_WAIT(); __builtin_amdgcn_sched_barrier(0);
#pragma unroll
                    for (int j = 0; j < 4; ++j) {
                        const float c0 = acc[ai][bj][0][n][j] * r[ai][0], c1 = acc[ai][bj][1][n][j] * r[ai][1], c2 = acc[ai][bj][2][n][j] * r[ai][2], c3 = acc[ai][bj][3][n][j] * r[ai][3];
                        const float x3 = dpp_shr1(q63[j], c3), x2 = dpp_shr1(q62[j], c2);
                        float v0 = fmaf(w0[j], x2, fmaf(w1[j], x3, w2[j] * c0));
                        float v1 = fmaf(w0[j], x3, fmaf(w1[j], c0, w2[j] * c1));
                        float v2 = fmaf(w0[j], c0, fmaf(w1[j], c1, w2[j] * c2));
                        float v3 = fmaf(w0[j], c1, fmaf(w1[j], c2, w2[j] * c3));
                        asm volatile("" : "+v"(v0), "+v"(v1), "+v"(v2), "+v"(v3));
                        acc[ai][bj][0][n][j] = v0; acc[ai][bj][1][n][j] = v1; acc[ai][bj][2][n][j] = v2; acc[ai][bj][3][n][j] = v3;
                    }
                    asm volatile("" ::: "memory"); __builtin_amdgcn_sched_barrier(0);
                }
#pragma unroll
            for (int m = 0; m < 4; ++m) { const int row = u.pm * 256 + 64 * strip + 4 * fr + m;
                float o[8];
#pragma unroll
                for (int n = 0; n < 2; ++n)
#pragma unroll
                    for (int j = 0; j < 4; ++j) { const float g = acc[ai][0][m][n][j]; o[4 * n + j] = g * fast_sigmoid(g) * acc[ai][1][m][n][j]; }
                store16_wt(ffrs, ((size_t)row * DFF + ch0) * 2, pack8(o)); }
            asm volatile("" ::: "memory"); __builtin_amdgcn_sched_barrier(0);
        }
        *last_pm = u.pm; *ui += 1;
    }
};
__device__ __forceinline__ void ff_fixup(const float* HALO, const float* cw, bf16_t* FF, int pm) {
    if ((pm & 15) == 0) return;
    constexpr int NIT = DFF / 4;
    const int t0 = opaque_tid();
    f32x4 hg[3][4], hv[3][4], wg[3][3], wv[3][3];
#pragma unroll
    for (int q = 0; q < 3; ++q) {
        const int it = t0 + 512 * q, itc = it < NIT ? it : NIT - 1, c4 = itc * 4, pn = c4 >> 7, jj = c4 & 127, tc = pn * 256 + jj;
        const float* T0 = HALO + (size_t)((pm - 1) * 4 + 2) * NUP + tc;
        const float* H0 = HALO + (size_t)(pm * 4) * NUP + tc;
        hg[q][0] = *(const f32x4*)T0; hg[q][1] = *(const f32x4*)(T0 + NUP); hg[q][2] = *(const f32x4*)H0; hg[q][3] = *(const f32x4*)(H0 + NUP);
        hv[q][0] = *(const f32x4*)(T0 + 128); hv[q][1] = *(const f32x4*)(T0 + NUP + 128); hv[q][2] = *(const f32x4*)(H0 + 128); hv[q][3] = *(const f32x4*)(H0 + NUP + 128);
#pragma unroll
        for (int k = 0; k < 3; ++k) { wg[q][k] = *(const f32x4*)(cw + k * NUP + c4); wv[q][k] = *(const f32x4*)(cw + k * NUP + DFF + c4); }
    }
#pragma unroll
    for (int q = 0; q < 3; ++q) {
#pragma unroll
        for (int k = 0; k < 4; ++k) asm volatile("" : "+v"(hg[q][k]), "+v"(hv[q][k]));
#pragma unroll
        for (int k = 0; k < 3; ++k) asm volatile("" : "+v"(wg[q][k]), "+v"(wv[q][k]));
    }
#pragma unroll
    for (int q = 0; q < 3; ++q) {
        const int it = t0 + 512 * q;
        if (it < NIT) {
#pragma unroll
            for (int rsel = 0; rsel < 2; ++rsel) {
                float o[4];
#pragma unroll
                for (int j = 0; j < 4; ++j) { const float g = wg[q][0][j] * hg[q][rsel][j] + wg[q][1][j] * hg[q][rsel + 1][j] + wg[q][2][j] * hg[q][rsel + 2][j];
                    const float v = wv[q][0][j] * hv[q][rsel][j] + wv[q][1][j] * hv[q][rsel + 1][j] + wv[q][2][j] * hv[q][rsel + 2][j]; o[j] = g * fast_sigmoid(g) * v; }
                u32x2 w; w.x = cvt_pk_bf16(o[0], o[1]); w.y = cvt_pk_bf16(o[2], o[3]);
                *(u32x2*)(FF + (size_t)(pm * 256 + rsel) * DFF + it * 4) = w;
            }
        }
    }
}
struct EpiDnNorm {
    static constexpr bool PERM = true, AFTER_DRAIN = true;
    float* X; const bf16_t* X1B; const float* gfin; float* SQ2; unsigned* cnt;
    __device__ __forceinline__ void fused(f32x4 (&acc)[2][2][4][2], const Unit& u, LAS unsigned char* lds) const {
        const int tid = opaque_tid(), wid = __builtin_amdgcn_readfirstlane(tid >> 6), lane = tid & 63, wr = wid >> 2, wc = wid & 3, fr = lane & 15, fq = lane >> 4;
        LAS float* part = (LAS float*)lds;
        LAS float* rs = part + 1024;
        const int row0 = u.pm * 256 + wr * 64 + fr, col0 = u.pn * 256 + wc * 32 + 8 * fq;
#pragma unroll
        for (int ai = 0; ai < 2; ++ai) {
            u32x4 xr[4][2];
#pragma unroll
            for (int m = 0; m < 4; ++m)
#pragma unroll
                for (int bj = 0; bj < 2; ++bj) xr[m][bj] = *(const u32x4*)(X1B + (size_t)x1b_phys_row(row0 + ai * 128 + m * 16) * D + col0 + bj * 128);
#pragma unroll
            for (int m = 0; m < 4; ++m)
#pragma unroll
                for (int bj = 0; bj < 2; ++bj) asm volatile("" : "+v"(xr[m][bj]));
#pragma unroll
            for (int m = 0; m < 4; ++m) { float ss = 0.f;
#pragma unroll
                for (int bj = 0; bj < 2; ++bj) { float xv[8]; unpack8(xr[m][bj], xv);
                    acc[ai][bj][m][0] += (f32x4){xv[0], xv[1], xv[2], xv[3]}; acc[ai][bj][m][1] += (f32x4){xv[4], xv[5], xv[6], xv[7]};
                    const f32x4 a = acc[ai][bj][m][0], b = acc[ai][bj][m][1];
                    ss += (a[0] * a[0] + a[1] * a[1]) + (a[2] * a[2] + a[3] * a[3]) + (b[0] * b[0] + b[1] * b[1]) + (b[2] * b[2] + b[3] * b[3]); }
                ss += __shfl_xor(ss, 16); ss += __shfl_xor(ss, 32);
                if (fq == 0) part[(ai * 128 + wr * 64 + m * 16 + fr) * 4 + wc] = ss; }
        }
        __syncthreads();
        if (tid < 256) { const f32x4 q = *(const LAS f32x4*)(part + tid * 4);
            __hip_atomic_store(SQ2 + ((size_t)u.pm * 8 + u.pn) * 256 + tid, (q[0] + q[1]) + (q[2] + q[3]), __ATOMIC_RELAXED, __HIP_MEMORY_SCOPE_AGENT); }
        asm volatile("s_waitcnt vmcnt(0)" ::: "memory");
        __syncthreads();
        if (tid == 0) {
            __hip_atomic_fetch_add(cnt + 64 * u.pm, 1u, __ATOMIC_RELAXED, __HIP_MEMORY_SCOPE_AGENT);
            for (int spin = 0; spin < (1 << 24); ++spin) { if (__hip_atomic_load(cnt + 64 * u.pm, __ATOMIC_RELAXED, __HIP_MEMORY_SCOPE_AGENT) >= 8u) break; __builtin_amdgcn_s_sleep(2); }
        }
        __syncthreads();
        if (tid < 256) { float tot = 0.f;
#pragma unroll
            for (int q = 0; q < 8; ++q) tot += __hip_atomic_load(SQ2 + ((size_t)u.pm * 8 + q) * 256 + tid, __ATOMIC_RELAXED, __HIP_MEMORY_SCOPE_AGENT);
            rs[tid] = 1.0f / sqrtf(tot * (1.0f / D) + EPS); }
        __syncthreads();
        f32x4 g[2][2];
#pragma unroll
        for (int bj = 0; bj < 2; ++bj) { g[bj][0] = *(const f32x4*)(gfin + col0 + bj * 128); g[bj][1] = *(const f32x4*)(gfin + col0 + bj * 128 + 4); }
#pragma unroll
        for (int ai = 0; ai < 2; ++ai)
#pragma unroll
            for (int m = 0; m < 4; ++m) { const int rl = ai * 128 + wr * 64 + m * 16 + fr; const float r = rs[rl]; float* o = X + (size_t)(u.pm * 256 + rl) * D + col0;
#pragma unroll
                for (int bj = 0; bj < 2; ++bj) { *(f32x4*)(o + bj * 128) = acc[ai][bj][m][0] * r * g[bj][0]; *(f32x4*)(o + bj * 128 + 4) = acc[ai][bj][m][1] * r * g[bj][1]; } }
    }
};

template <bool NTOUT>
__device__ __forceinline__ void p0_item64(const float* __restrict__ W, int K, int N, bf16_t* __restrict__ WT, const float* __restrict__ gk, LAS float* scr, int kb, int nb, int out_row0, int lane) {
    const int k0 = 64 * kb, n0 = 64 * nb, kq = lane >> 4, nq = 4 * (lane & 15);
    f32x4 v[16];
#pragma unroll
    for (int i = 0; i < 16; ++i) v[i] = __builtin_nontemporal_load((const f32x4*)(W + (size_t)(k0 + 4 * i + kq) * N + n0 + nq));
    if (gk) {
#pragma unroll
        for (int i = 0; i < 16; ++i) v[i] *= gk[k0 + 4 * i + kq];
    }
#pragma unroll
    for (int i = 0; i < 16; ++i) { LAS float* d = scr + (4 * i + kq) * 65 + nq; d[0] = v[i][0]; d[1] = v[i][1]; d[2] = v[i][2]; d[3] = v[i][3]; }
    LDS_WAIT();
    const int c = lane & 7;
#pragma unroll
    for (int j = 0; j < 8; ++j) { const int n = (lane >> 3) + 8 * j; const LAS float* s = scr + (8 * c) * 65 + n;
        u32x4 o; o.x = cvt_pk_bf16(s[0 * 65], s[1 * 65]); o.y = cvt_pk_bf16(s[2 * 65], s[3 * 65]); o.z = cvt_pk_bf16(s[4 * 65], s[5 * 65]); o.w = cvt_pk_bf16(s[6 * 65], s[7 * 65]);
        if (NTOUT) __builtin_nontemporal_store(o, (u32x4*)(WT + (size_t)(out_row0 + n) * K + k0 + 8 * c)); else *(u32x4*)(WT + (size_t)(out_row0 + n) * K + k0 + 8 * c) = o; }
    LDS_WAIT();
}
template <bool UPPERM, bool NTOUT = false>
__device__ __forceinline__ void convert_matrix(const float* W, int K, int N, bf16_t* WT, const float* gk, LAS unsigned char* lds, int wk, int nworkers) {
    const int tid = opaque_tid(), lane = tid & 63, wave = tid >> 6;
    LAS float* scr = (LAS float*)(lds + wave * 16640);
    const int nblk = N / 64, items = (K / 64) * nblk;
    for (int it = wk * 8 + wave; it < items; it += nworkers * 8) {
        const int kb = it / nblk, nb = it % nblk;
        int orow = 64 * nb;
        if (UPPERM) { const int bj = nb / (DFF / 64), rem = nb % (DFF / 64); orow = 256 * (rem >> 1) + 128 * bj + 64 * (rem & 1); }
        p0_item64<NTOUT>(W, K, N, WT, gk, scr, kb, nb, orow, lane);
    }
}

__device__ __forceinline__ void phase0(const Params& p, LAS unsigned char* lds) {
    const int tid = opaque_tid(), lane = tid & 63, wave = tid >> 6;
    const int gw = blockIdx.x * 8 + wave, NGW = gridDim.x * 8;
    unsigned char* ws = p.ws;
    const float* x = p.in[0]; const float* g = p.in[1]; bf16_t* H = (bf16_t*)(ws + OFF_HREG);
    for (int m = gw * 2; m < MTOK; m += NGW * 2) {
        const f32x4* xr = (const f32x4*)(x + (size_t)m * D) + lane; const f32x4* gr = (const f32x4*)g + lane;
        f32x4 v[2][8]; float s0 = 0.f, s1 = 0.f;
#pragma unroll
        for (int j = 0; j < 8; ++j) { v[0][j] = __builtin_nontemporal_load(xr + 64 * j); v[1][j] = __builtin_nontemporal_load(xr + 512 + 64 * j); }
#pragma unroll
        for (int j = 0; j < 8; ++j) { s0 += (v[0][j][0] * v[0][j][0] + v[0][j][1] * v[0][j][1]) + (v[0][j][2] * v[0][j][2] + v[0][j][3] * v[0][j][3]);
                                      s1 += (v[1][j][0] * v[1][j][0] + v[1][j][1] * v[1][j][1]) + (v[1][j][2] * v[1][j][2] + v[1][j][3] * v[1][j][3]); }
        const float rs0 = 1.0f / sqrtf(wave_sum(s0) * (1.0f / D) + EPS), rs1 = 1.0f / sqrtf(wave_sum(s1) * (1.0f / D) + EPS);
        u32x2* o = (u32x2*)(H + (size_t)m * D) + lane;
#pragma unroll
        for (int j = 0; j < 8; ++j) { const f32x4 gg = gr[64 * j]; u32x2 w;
            w.x = cvt_pk_bf16(v[0][j][0] * rs0 * gg[0], v[0][j][1] * rs0 * gg[1]); w.y = cvt_pk_bf16(v[0][j][2] * rs0 * gg[2], v[0][j][3] * rs0 * gg[3]); o[64 * j] = w;
            w.x = cvt_pk_bf16(v[1][j][0] * rs1 * gg[0], v[1][j][1] * rs1 * gg[1]); w.y = cvt_pk_bf16(v[1][j][2] * rs1 * gg[2], v[1][j][3] * rs1 * gg[3]); o[512 + 64 * j] = w; }
    }
    if (blockIdx.x == 0 && tid < 64) ((unsigned*)(ws + OFF_CNT))[64 * tid] = 0u;
    const int G = gridDim.x, c = blockIdx.x;
    convert_matrix<false>(p.in[2], D, NIN, (bf16_t*)(ws + OFF_WINT), nullptr, lds, c, G);
}

constexpr int BP = 72;
constexpr int FP = 68;
constexpr int LRU_WAVE_LDS = 16 * BP * 2 + 2 * 16 * FP * 4;
constexpr int LRU_UNITS = NB * NH * 8;
__device__ __forceinline__ void lru_partA(const Params& p, LAS unsigned char* lds, int unit, float (&hloc)[64], float (&cumA)[64], float& Aex, float& hex, unsigned (&gpk)[32]) {
    const int tid = opaque_tid(), lane = tid & 63, wave = __builtin_amdgcn_readfirstlane(tid >> 6);
    const int bc = unit & 7, hd = (unit >> 3) & (NH - 1), b = unit >> 7;
    const int ch0 = hd * HD, tw0 = bc * 512 + wave * 64;
    LAS bf16_t* wab = (LAS bf16_t*)lds; LAS bf16_t* wxb = wab + 64 * BP;
    LAS float* totA = (LAS float*)(lds + 18432); LAS float* totH = totA + 512;
    LAS unsigned char* wl = lds + 22528 + wave * LRU_WAVE_LDS;
    LAS bf16_t* xcb = (LAS bf16_t*)wl; LAS float* us = (LAS float*)(wl + 16 * BP * 2); LAS float* as_ = us + 16 * FP;
    const bf16_t* P = (const bf16_t*)(p.ws + OFF_P);
    const float* cw = p.in[3]; const float* cb = p.in[4]; const float* wa = p.in[5]; const float* ba = p.in[6]; const float* wx = p.in[7]; const float* bx = p.in[8]; const float* lam = p.in[9];
    {
        const int e = tid * 8, i = e >> 6, j0 = e & 63;
        const float* s1 = wa + (size_t)hd * 4096 + e; const float* s2 = wx + (size_t)hd * 4096 + e;
        const f32x4 a0 = *(const f32x4*)s1, a1 = *(const f32x4*)(s1 + 4), x0 = *(const f32x4*)s2, x1 = *(const f32x4*)(s2 + 4);
        const float av[8] = {a0[0], a0[1], a0[2], a0[3], a1[0], a1[1], a1[2], a1[3]}; const float xv[8] = {x0[0], x0[1], x0[2], x0[3], x1[0], x1[1], x1[2], x1[3]};
#pragma unroll
        for (int q = 0; q < 8; ++q) { wab[(j0 + q) * BP + i] = (bf16_t)(cvt_pk_bf16(av[q], 0.f) & 0xffffu); wxb[(j0 + q) * BP + i] = (bf16_t)(cvt_pk_bf16(xv[q], 0.f) & 0xffffu); }
    }
    const int ctl = lane >> 3, c8 = (lane & 7) * 8;
    float w4[4][8], bb[8];
#pragma unroll
    for (int k = 0; k < 4; ++k) { const f32x4 q0 = *(const f32x4*)(cw + k * DL + ch0 + c8), q1 = *(const f32x4*)(cw + k * DL + ch0 + c8 + 4);
        w4[k][0] = q0[0]; w4[k][1] = q0[1]; w4[k][2] = q0[2]; w4[k][3] = q0[3]; w4[k][4] = q1[0]; w4[k][5] = q1[1]; w4[k][6] = q1[2]; w4[k][7] = q1[3]; }
    { const f32x4 q0 = *(const f32x4*)(cb + ch0 + c8), q1 = *(const f32x4*)(cb + ch0 + c8 + 4); bb[0] = q0[0]; bb[1] = q0[1]; bb[2] = q0[2]; bb[3] = q0[3]; bb[4] = q1[0]; bb[5] = q1[1]; bb[6] = q1[2]; bb[7] = q1[3]; }
    const int r16 = lane & 15, quad = lane >> 4;
    float bav[4], bxv[4], sp8[4];
#pragma unroll
    for (int ct = 0; ct < 4; ++ct) { const int ch = ch0 + 16 * ct + r16; bav[ct] = ba[ch]; bxv[ct] = bx[ch]; sp8[ct] = -8.0f * log1pf(__expf(-lam[ch])); }
    __syncthreads();
    float h = 0.f, A = 1.f;
#pragma unroll
    for (int sc = 0; sc < 4; ++sc) {
        const int ts0 = tw0 + 16 * sc;
#pragma unroll
        for (int ps = 0; ps < 2; ++ps) {
            const int tl = ps * 8 + ctl;
            float xc[8];
#pragma unroll
            for (int j = 0; j < 8; ++j) xc[j] = bb[j];
#pragma unroll
            for (int k = 0; k < 4; ++k) {
                const int tt = ts0 + tl - 3 + k;
                if (tt >= 0) { float xin[8]; unpack8(*(const u32x4*)(P + (size_t)(b * SEQ + tt) * NIN + PC_LX + ch0 + c8), xin);
#pragma unroll
                    for (int j = 0; j < 8; ++j) xc[j] += w4[k][j] * xin[j]; }
            }
            *(LAS f32x4*)(us + tl * FP + c8) = (f32x4){xc[0], xc[1], xc[2], xc[3]}; *(LAS f32x4*)(us + tl * FP + c8 + 4) = (f32x4){xc[4], xc[5], xc[6], xc[7]};
            *(LAS u32x4*)(xcb + tl * BP + c8) = pack8(xc);
        }
        LDS_WAIT();
        {
            bf16x8 af[2];
#pragma unroll
            for (int kk = 0; kk < 2; ++kk) af[kk] = *(const LAS bf16x8*)(xcb + r16 * BP + kk * 32 + quad * 8);
#pragma unroll
            for (int ct = 0; ct < 4; ++ct) {
                f32x4 ar = {0.f, 0.f, 0.f, 0.f}, ai = {0.f, 0.f, 0.f, 0.f};
#pragma unroll
                for (int kk = 0; kk < 2; ++kk) {
                    const bf16x8 b1 = *(const LAS bf16x8*)(wab + (16 * ct + r16) * BP + kk * 32 + quad * 8);
                    const bf16x8 b2 = *(const LAS bf16x8*)(wxb + (16 * ct + r16) * BP + kk * 32 + quad * 8);
                    ar = __builtin_amdgcn_mfma_f32_16x16x32_bf16(af[kk], b1, ar, 0, 0, 0);
                    ai = __builtin_amdgcn_mfma_f32_16x16x32_bf16(af[kk], b2, ai, 0, 0, 0);
                }
                const int j = 16 * ct + r16;
#pragma unroll
                for (int rg = 0; rg < 4; ++rg) {
                    const int t = quad * 4 + rg;
                    const float r = fast_sigmoid(ar[rg] + bav[ct]), ig = fast_sigmoid(ai[rg] + bxv[ct]);
                    const float a = __builtin_amdgcn_exp2f(1.4426950408889634f * (sp8[ct] * r)), mult = sqrtf(fmaxf(fmaf(-a, a, 1.0f), 0.f));
                    const float xc = us[t * FP + j];
                    us[t * FP + j] = mult * (ig * xc); as_[t * FP + j] = a;
                }
            }
        }
        LDS_WAIT();
#pragma unroll
        for (int s = 0; s < 16; ++s) { const float a = as_[s * FP + lane], uu = us[s * FP + lane]; h = a * h + uu; A *= a; hloc[sc * 16 + s] = h; cumA[sc * 16 + s] = A; }
        LDS_WAIT();
    }
    totA[wave * 64 + lane] = A; totH[wave * 64 + lane] = h;
    {
        const bf16_t* G = P + (size_t)(b * SEQ + tw0) * NIN + PC_LG + ch0 + lane;
#pragma unroll
        for (int s2 = 0; s2 < 32; ++s2) gpk[s2] = (unsigned)G[(size_t)(2 * s2) * NIN] | ((unsigned)G[(size_t)(2 * s2 + 1) * NIN] << 16);
    }
    __syncthreads();
    Aex = 1.f; hex = 0.f;
    for (int w = 0; w < wave; ++w) { const float a = totA[w * 64 + lane], hh = totH[w * 64 + lane]; hex = a * hex + hh; Aex *= a; }
    if (wave == 7) {
        const size_t o = (size_t)(b * 8 + bc) * DL + ch0 + lane;
        __hip_atomic_store((float*)(p.ws + OFF_LA) + o, Aex * A, __ATOMIC_RELAXED, __HIP_MEMORY_SCOPE_AGENT);
        __hip_atomic_store((float*)(p.ws + OFF_LH) + o, A * hex + h, __ATOMIC_RELAXED, __HIP_MEMORY_SCOPE_AGENT);
        asm volatile("s_waitcnt vmcnt(0)" ::: "memory");
        if (lane == 0) __hip_atomic_fetch_add((unsigned*)(p.ws + OFF_CNT) + 64 * (32 + b * NH + hd), 1u, __ATOMIC_RELAXED, __HIP_MEMORY_SCOPE_AGENT);
    }
}
__device__ __forceinline__ void lru_partB(const Params& p, int unit, const float (&hloc)[64], const float (&cumA)[64], float Aex, float hex, const unsigned (&gpk)[32]) {
    const int tid = opaque_tid(), lane = tid & 63, wave = __builtin_amdgcn_readfirstlane(tid >> 6);
    const int bc = unit & 7, hd = (unit >> 3) & (NH - 1), b = unit >> 7;
    const int ch0 = hd * HD, tw0 = bc * 512 + wave * 64;
    const float* LA = (const float*)(p.ws + OFF_LA); const float* LH = (const float*)(p.ws + OFF_LH);
    if (bc > 0) {
        if (tid == 0) { unsigned* cn = (unsigned*)(p.ws + OFF_CNT) + 64 * (32 + b * NH + hd);
            for (int spin = 0; spin < (1 << 24); ++spin) { if (__hip_atomic_load(cn, __ATOMIC_RELAXED, __HIP_MEMORY_SCOPE_AGENT) >= 8u) break; __builtin_amdgcn_s_sleep(1); } }
        __syncthreads();
    }
    float hin = 0.f;
    for (int c2 = 0; c2 < bc; ++c2) { const size_t o = (size_t)(b * 8 + c2) * DL + ch0 + lane;
        hin = __hip_atomic_load((float*)LA + o, __ATOMIC_RELAXED, __HIP_MEMORY_SCOPE_AGENT) * hin + __hip_atomic_load((float*)LH + o, __ATOMIC_RELAXED, __HIP_MEMORY_SCOPE_AGENT); }
    const float hw = Aex * hin + hex;
    bf16_t* O = (bf16_t*)(p.ws + OFF_HREG) + (size_t)(b * SEQ + tw0) * DL + ch0 + lane;
#pragma unroll
    for (int s = 0; s < 64; ++s) { const float gt = (s & 1) ? bf_hi(gpk[s >> 1]) : bf_lo(gpk[s >> 1]);
        O[(size_t)s * DL] = (bf16_t)(cvt_pk_bf16((hloc[s] + cumA[s] * hw) * gt, 0.f) & 0xffffu); }
}

__device__ __forceinline__ void sc_item_load(const bf16_t* P, int it, u32x4 (&cv)[3], u32x4 (&vv)[3], u32x4& bv) {
    const int row = it / (DS / 8), c8 = (it % (DS / 8)) * 8, t = row % SEQ;
#pragma unroll
    for (int k = 0; k < 3; ++k) {
        const int rr = (t - 2 + k >= 0) ? (row - 2 + k) : row;
        const bf16_t* pr = P + (size_t)rr * NIN + c8;
        cv[k] = *(const u32x4*)(pr + PC_SC); vv[k] = *(const u32x4*)(pr + PC_SV);
    }
    bv = *(const u32x4*)(P + (size_t)row * NIN + PC_SB + c8);
}
__device__ __forceinline__ void sc_item_finish(const float* cw, bf16_t* ASC, int it, const u32x4 (&cv)[3], const u32x4 (&vv)[3], const u32x4& bv) {
    const int row = it / (DS / 8), c8 = (it % (DS / 8)) * 8, t = row % SEQ;
    float acc[8] = {0.f, 0.f, 0.f, 0.f, 0.f, 0.f, 0.f, 0.f};
#pragma unroll
    for (int k = 0; k < 3; ++k) {
        float c[8], v[8]; unpack8(cv[k], c); unpack8(vv[k], v);
        const f32x4 w0 = *(const f32x4*)(cw + k * DS + c8), w1 = *(const f32x4*)(cw + k * DS + c8 + 4);
        const float wv[8] = {w0[0], w0[1], w0[2], w0[3], w1[0], w1[1], w1[2], w1[3]};
        const float msk = (t - 2 + k >= 0) ? 1.0f : 0.0f;
#pragma unroll
        for (int j = 0; j < 8; ++j) acc[j] += (msk * wv[j]) * (c[j] * v[j]);
    }
    float b[8]; unpack8(bv, b);
#pragma unroll
    for (int j = 0; j < 8; ++j) acc[j] *= b[j];
    *(u32x4*)(ASC + (size_t)row * DS + c8) = pack8(acc);
}
__device__ __forceinline__ void sc_phase(const Params& p) {
    const bf16_t* P = (const bf16_t*)(p.ws + OFF_P);
    bf16_t* ASC = (bf16_t*)(p.ws + OFF_HREG) + (size_t)MTOK * DL;
    const float* cw = p.in[11];
    const int nth = gridDim.x * 512, NIT = MTOK * (DS / 8);
    for (int it = blockIdx.x * 512 + opaque_tid(); it < NIT; it += 4 * nth) {
        u32x4 cv[4][3], vv[4][3], bv[4];
#pragma unroll
        for (int q = 0; q < 4; ++q) if (it + q * nth < NIT) sc_item_load(P, it + q * nth, cv[q], vv[q], bv[q]);
#pragma unroll
        for (int q = 0; q < 4; ++q) if (it + q * nth < NIT) sc_item_finish(cw, ASC, it + q * nth, cv[q], vv[q], bv[q]);
    }
}

__device__ __forceinline__ void final_norm_phase(const Params& p) {
    const int tid = opaque_tid(), lane = tid & 63, wave = tid >> 6;
    const int gw = blockIdx.x * 8 + wave, NGW = gridDim.x * 8;
    const float* g = p.in[18];
    for (int m = gw; m < MTOK; m += NGW) {
        f32x4* xr = (f32x4*)(p.out + (size_t)m * D) + lane; const f32x4* gr = (const f32x4*)g + lane;
        f32x4 v[8]; float s = 0.f;
#pragma unroll
        for (int j = 0; j < 8; ++j) { v[j] = xr[64 * j]; s += (v[j][0] * v[j][0] + v[j][1] * v[j][1]) + (v[j][2] * v[j][2] + v[j][3] * v[j][3]); }
        const float rstd = 1.0f / sqrtf(wave_sum(s) * (1.0f / D) + EPS);
#pragma unroll
        for (int j = 0; j < 8; ++j) { const f32x4 gg = gr[64 * j]; xr[64 * j] = (f32x4){v[j][0] * rstd * gg[0], v[j][1] * rstd * gg[1], v[j][2] * rstd * gg[2], v[j][3] * rstd * gg[3]}; }
    }
}

#define XB_TMO      128
#define XB_XCNT(j)  (256  + 64 * (j))
#define XB_XSUB(j)  (1280 + 64 * (j))
#define XB_XGEN(j)  (2304 + 64 * (j))
#define XB_TOP      3328
#define XB_TOPGEN   3392
#define XCD_BAR_WORDS 3456
#define XB_SPIN_CAP (1u << 18)

__device__ __forceinline__ unsigned xb_ld(unsigned* p)              { return __hip_atomic_load(p, __ATOMIC_RELAXED, __HIP_MEMORY_SCOPE_AGENT); }
__device__ __forceinline__ unsigned xb_add(unsigned* p, unsigned v) { return __hip_atomic_fetch_add(p, v, __ATOMIC_RELAXED, __HIP_MEMORY_SCOPE_AGENT); }
__device__ __forceinline__ unsigned xb_xcc_id() { return (unsigned)__builtin_amdgcn_s_getreg((3 << 11) | 20) & 0xFu; }
#define XB_SPIN(cond, bar) do { unsigned _sp = 0; while (cond) { __builtin_amdgcn_s_sleep(1); \
    if ((++_sp & 255u) == 0u) { if (xb_ld(&(bar)[XB_TMO])) break; if (_sp > XB_SPIN_CAP) { atomicAdd(&(bar)[XB_TMO], 1u); break; } } } } while (0)

struct XcdBarrier {
    unsigned* bar; unsigned x;
    volatile LAS unsigned* st;
};

__device__ __forceinline__ XcdBarrier xcd_barrier_post(unsigned* bar, volatile LAS unsigned* st) {
    XcdBarrier b; b.bar = bar; b.x = xb_xcc_id(); b.st = st;
    if (threadIdx.x == 0) (void)xb_add(&bar[XB_XCNT(b.x)], 1u);
    return b;
}
__device__ __forceinline__ void xcd_barrier_complete(unsigned* bar, unsigned x, unsigned& nloc, unsigned& nx) {
    const unsigned G = gridDim.x * gridDim.y * gridDim.z;
    unsigned sum, cnt, mine, sp = 0u;
    for (;;) {
        sum = 0u; cnt = 0u; mine = 0u;
#pragma unroll
        for (unsigned j = 0; j < 16; ++j) { const unsigned c = xb_ld(&bar[XB_XCNT(j)]); sum += c; cnt += (c > 0u) ? 1u : 0u; mine = (j == x) ? c : mine; }
        if (sum == G) break;
        __builtin_amdgcn_s_sleep(1);
        if ((++sp & 255u) == 0u) { if (xb_ld(&bar[XB_TMO])) break; if (sp > XB_SPIN_CAP) { atomicAdd(&bar[XB_TMO], 1u); break; } }
    }
    nloc = mine > 0u ? mine : 1u; nx = cnt > 0u ? cnt : 1u;
}

__device__ __forceinline__ void xcd_barrier(const XcdBarrier& b) {
    asm volatile("s_waitcnt vmcnt(0)" ::: "memory");
    __syncthreads();
    if (threadIdx.x == 0) {
        unsigned* bar = b.bar;
        __builtin_amdgcn_s_waitcnt(0);
        unsigned nloc = b.st[0], nx = b.st[1];
        if (nloc == 0u) { xcd_barrier_complete(bar, b.x, nloc, nx); b.st[0] = nloc; b.st[1] = nx; }
        const unsigned old = xb_add(&bar[XB_XSUB(b.x)], 1u);
        const unsigned gen = old / nloc;
        if (old + 1u == (gen + 1u) * nloc) {
            __builtin_amdgcn_fence(__ATOMIC_RELEASE, "agent");
            asm volatile("s_waitcnt vmcnt(0)" ::: "memory");
            const unsigned og = xb_add(&bar[XB_TOP], 1u);
            const unsigned tg = og / nx;
            if (og + 1u == (tg + 1u) * nx) xb_add(&bar[XB_TOPGEN], 1u);
            else XB_SPIN(xb_ld(&bar[XB_TOPGEN]) == tg, bar);
            __builtin_amdgcn_fence(__ATOMIC_ACQUIRE, "agent");
            xb_add(&bar[XB_XGEN(b.x)], 1u);
            asm volatile("s_waitcnt vmcnt(0)" ::: "memory");
        } else {
            XB_SPIN(xb_ld(&bar[XB_XGEN(b.x)]) == gen, bar);
            __builtin_amdgcn_fence(__ATOMIC_ACQUIRE, "agent");
            asm volatile("s_waitcnt vmcnt(0)" ::: "memory");
        }
    }
    __syncthreads();
}


__global__ void __launch_bounds__(512, 2) mega_fwd(Params p) {
    extern __shared__ __attribute__((aligned(16))) unsigned char lds_raw[];
    LAS unsigned char* lds = (LAS unsigned char*)lds_raw;
    unsigned char* ws = p.ws;
    const int G = gridDim.x, c = blockIdx.x;
    LAS unsigned* stw = (LAS unsigned*)(lds + LDS_BYTES - 16);
    if (threadIdx.x < 4) stw[threadIdx.x] = 0u;
    __syncthreads();
    const XcdBarrier xb = xcd_barrier_post((unsigned*)(ws + OFF_BAR), (volatile LAS unsigned*)stw);

    phase0(p, lds);
    xcd_barrier(xb);
    {
        pg8::Gemm g{(const bf16_t*)(ws + OFF_HREG), (const bf16_t*)(ws + OFF_WINT), MTOK, NIN, D, nullptr, nullptr}; pg8::StaticOrder S; S.init(MTOK, NIN, G, c);
        EpiIn E{(bf16_t*)(ws + OFF_P)};
        pg8::gemm_phase<EpiIn, pg8::StaticOrder>(lds, g, S, E);
        const int rem = S.nwg % G;
        if (rem == 0 || c >= rem) {
            const int wk = rem ? c - rem : c, nwk = rem ? G - rem : G;
            convert_matrix<false, true>(p.in[10], DL, D, (bf16_t*)(ws + OFF_WLRU), nullptr, lds, wk, nwk);
            convert_matrix<false, true>(p.in[12], DS, D, (bf16_t*)(ws + OFF_WSC), nullptr, lds, wk, nwk);
            convert_matrix<false, true>(p.in[13], D, D, (bf16_t*)(ws + OFF_WO), nullptr, lds, wk, nwk);
            convert_matrix<true, true>(p.in[15], D, NUP, (bf16_t*)(ws + OFF_WUP), p.in[14], lds, wk, nwk);
        }
    }
    xcd_barrier(xb);
    sc_phase(p);
    {
        float hloc[64], cumA[64], Aex = 1.f, hex = 0.f; unsigned gpk[32];
        const bool has_unit = c < LRU_UNITS;
        if (has_unit) { lru_partA(p, lds, c, hloc, cumA, Aex, hex, gpk); lru_partB(p, c, hloc, cumA, Aex, hex, gpk); }
    }
    xcd_barrier(xb);
    {
        pg8::StaticOrder S; S.init(MTOK, D, G, c);
        pg8::Gemm g{(const bf16_t*)(ws + OFF_HREG), (const bf16_t*)(ws + OFF_WLRU), MTOK, D, DL, (const bf16_t*)(ws + OFF_HREG) + (size_t)MTOK * DL, (const bf16_t*)(ws + OFF_WSC)};
        EpiMix E{(const bf16_t*)(ws + OFF_P), (bf16_t*)(ws + OFF_MRG)};
        pg8::gemm_phase<EpiMix, pg8::StaticOrder, 2>(lds, g, S, E);
    }
    xcd_barrier(xb);
    {
        pg8::Gemm g{(const bf16_t*)(ws + OFF_MRG), (const bf16_t*)(ws + OFF_WO), MTOK, D, D, nullptr, nullptr}; pg8::StaticOrder S; S.init(MTOK, D, G, c);
        EpiO E{p.in[0], (bf16_t*)(ws + OFF_HREG), (float*)(ws + OFF_SQ)};
        pg8::gemm_phase<EpiO, pg8::StaticOrder>(lds, g, S, E);
    }
    xcd_barrier(xb);
    {
        pg8::Gemm g{(const bf16_t*)(ws + OFF_HREG), (const bf16_t*)(ws + OFF_WUP), MTOK, NUP, D, nullptr, nullptr}; pg8::StaticOrder S; S.init(MTOK, NUP, G, c);
        int last_pm = -1, epi_ui = 0;
        {
            LAS float* wl0 = (LAS float*)(lds + pg8::STAGE_BYTES) + 2048 + 256;
            Unit uu; const int t0 = opaque_tid();
            for (int i = 0; i < 6 && S.next(i, uu); ++i)
                if (t0 < 192) { const int k = t0 >> 6, q = t0 & 63, bj = q >> 5;
                    *(LAS f32x4*)(wl0 + 768 * i + k * 256 + 4 * q) = *(const f32x4*)(p.in[16] + k * NUP + bj * DFF + uu.pn * 128 + ((4 * q) & 127)); }
            __syncthreads();
        }
        EpiUpConv E{(const float*)(ws + OFF_SQ), (bf16_t*)(ws + OFF_FF), p.in[16], (float*)(ws + OFF_HALO), (LAS float*)(lds + pg8::STAGE_BYTES), &last_pm, &epi_ui};
        pg8::gemm_phase<EpiUpConv, pg8::StaticOrder>(lds, g, S, E);
        const int rem = S.nwg % G;
        if (rem == 0) convert_matrix<false, true>(p.in[17], DFF, D, (bf16_t*)(ws + OFF_WDN), nullptr, lds, c, G);
        else if (c >= rem) convert_matrix<false, true>(p.in[17], DFF, D, (bf16_t*)(ws + OFF_WDN), nullptr, lds, c - rem, G - rem);
    }
    xcd_barrier(xb);
    {
        pg8::Gemm g{(const bf16_t*)(ws + OFF_FF), (const bf16_t*)(ws + OFF_WDN), MTOK, D, DFF, nullptr, nullptr}; pg8::StaticOrder S; S.init(MTOK, D, G, c);
        { Unit u; for (int ui = 0; S.next(ui, u); ++ui) ff_fixup((const float*)(ws + OFF_HALO), p.in[16], (bf16_t*)(ws + OFF_FF), u.pm);
          asm volatile("s_waitcnt vmcnt(0)" ::: "memory"); __syncthreads(); }
        EpiDnNorm E{p.out, (const bf16_t*)(ws + OFF_HREG), p.in[18], (float*)(ws + OFF_SQ2), (unsigned*)(ws + OFF_CNT)};
        pg8::gemm_phase<EpiDnNorm, pg8::StaticOrder>(lds, g, S, E);
    }
}

extern "C" void kernel_launch(void* const* d_in, const int* in_sizes, int n_in, void* d_out, int out_size, void* d_ws, size_t ws_size, hipStream_t stream) {
    static int grid_blocks = 0;
    if (grid_blocks == 0) {
        if (n_in != 19 || out_size != MTOK * D || ws_size < WS_END) { fprintf(stderr, "kernel_launch: unexpected shapes (n_in %d out %d ws %zu, need %zu)\n", n_in, out_size, ws_size, (size_t)WS_END); grid_blocks = -1; return; }
        int dev = 0, cus = 0, per_cu = 0;
        (void)hipGetDevice(&dev);
        (void)hipDeviceGetAttribute(&cus, hipDeviceAttributeMultiprocessorCount, dev);
        (void)hipFuncSetAttribute((const void*)mega_fwd, hipFuncAttributeMaxDynamicSharedMemorySize, LDS_BYTES);
        (void)hipOccupancyMaxActiveBlocksPerMultiprocessor(&per_cu, (const void*)mega_fwd, 512, LDS_BYTES);
        if (per_cu < 1) { fprintf(stderr, "kernel_launch: occupancy query says %d blocks/CU: nothing launched\n", per_cu); grid_blocks = -1; return; }
        if (cus < LRU_UNITS) { fprintf(stderr, "kernel_launch: needs >= %d CUs (got %d)\n", LRU_UNITS, cus); grid_blocks = -1; return; }
        grid_blocks = cus * (per_cu < 1 ? per_cu : 1);
    }
    if (grid_blocks < 0) return;
    Params p{};
    for (int i = 0; i < 19; ++i) p.in[i] = (const float*)d_in[i];
    p.out = (float*)d_out; p.ws = (unsigned char*)d_ws;
    (void)hipMemsetAsync((char*)d_ws + OFF_BAR, 0, XCD_BAR_WORDS * 4, stream);
    void* args[] = {&p};
    hipError_t e = hipLaunchCooperativeKernel((const void*)mega_fwd, dim3(grid_blocks), dim3(512), args, LDS_BYTES, stream);
    if (e != hipSuccess) fprintf(stderr, "cooperative launch failed: %s (grid %d)\n", hipGetErrorString(e), grid_blocks);
}
```

```cpp
#include <hip/hip_runtime.h>
#include <cstdio>

#ifndef NAIVE_KLOOP
#define NAIVE_KLOOP 0
#endif

#define LAS __attribute__((address_space(3)))
typedef unsigned short bf16_t;
typedef short bf16x8 __attribute__((ext_vector_type(8)));
typedef float f32x4 __attribute__((ext_vector_type(4)));
typedef float f32x2 __attribute__((ext_vector_type(2)));
typedef unsigned u32x4 __attribute__((ext_vector_type(4)));
typedef unsigned u32x2 __attribute__((ext_vector_type(2)));

constexpr int SEQ = 4096, NB = 2, MTOK = NB * SEQ;
constexpr int D = 2048, DL = 1024, DS = 1024, DFF = 5632, NUP = 2 * DFF, NIN = 2 * DL + 3 * DS + 2 * D;
constexpr int NH = 16, HD = 64;
constexpr float EPS = 1e-6f;
constexpr int PC_LX = 0, PC_LG = 1024, PC_SB = 2048, PC_SC = 3072, PC_SV = 4096, PC_GL = 5120, PC_GS = 7168;
constexpr int LNCH = 8;

constexpr size_t OFF_WINT = 0;
constexpr size_t OFF_WLRU = OFF_WINT + (size_t)NIN * D * 2;
constexpr size_t OFF_WSC  = OFF_WLRU + (size_t)D * DL * 2;
constexpr size_t OFF_WO   = OFF_WSC + (size_t)D * DS * 2;
constexpr size_t OFF_HREG = OFF_WO + (size_t)D * D * 2;
constexpr size_t OFF_WUP  = (size_t)MTOK * DFF * 2;
constexpr size_t OFF_WDN  = OFF_WUP + (size_t)NUP * D * 2;
constexpr size_t OFF_P    = OFF_WDN + (size_t)D * DFF * 2;
constexpr size_t OFF_MRG  = OFF_P + (size_t)MTOK * NIN * 2;
constexpr size_t OFF_FF   = OFF_P;
constexpr size_t OFF_SQ   = OFF_MRG + (size_t)MTOK * D * 2;
constexpr size_t OFF_LA   = OFF_SQ + (size_t)MTOK * 32 * 4;
constexpr size_t OFF_LH   = OFF_LA + (size_t)NB * LNCH * DL * 4;
constexpr size_t OFF_HALO = OFF_LH + (size_t)NB * LNCH * DL * 4;
constexpr size_t OFF_SQ2  = OFF_HALO + (size_t)(MTOK / 256) * 4 * NUP * 4;
constexpr size_t OFF_CNT  = OFF_SQ2 + (size_t)(MTOK / 256) * 8 * 256 * 4;
constexpr size_t OFF_BAR  = OFF_CNT + (size_t)64 * 256;
constexpr size_t WS_END   = OFF_BAR + 3456 * 4;
static_assert(OFF_HREG + (size_t)MTOK * D * 2 <= OFF_WUP, "ws overlap");

constexpr int LDS_BYTES = 160 * 1024;

struct Params { const float* in[19]; float* out; unsigned char* ws; };

__device__ __forceinline__ unsigned cvt_pk_bf16(float lo, float hi) { unsigned r; asm volatile("v_cvt_pk_bf16_f32 %0, %1, %2" : "=v"(r) : "v"(lo), "v"(hi)); return r; }
__device__ __forceinline__ float bf_lo(unsigned w) { return __uint_as_float(w << 16); }
__device__ __forceinline__ float bf_hi(unsigned w) { return __uint_as_float(w & 0xffff0000u); }
__device__ __forceinline__ void unpack8(const u32x4 w, float (&f)[8]) {
    f[0] = bf_lo(w.x); f[1] = bf_hi(w.x); f[2] = bf_lo(w.y); f[3] = bf_hi(w.y); f[4] = bf_lo(w.z); f[5] = bf_hi(w.z); f[6] = bf_lo(w.w); f[7] = bf_hi(w.w);
}
__device__ __forceinline__ u32x4 pack8(const float (&f)[8]) { u32x4 o; o.x = cvt_pk_bf16(f[0], f[1]); o.y = cvt_pk_bf16(f[2], f[3]); o.z = cvt_pk_bf16(f[4], f[5]); o.w = cvt_pk_bf16(f[6], f[7]); return o; }
__device__ __forceinline__ float fast_sigmoid(float x) { return __builtin_amdgcn_rcpf(1.0f + __builtin_amdgcn_exp2f(-1.4426950408889634f * x)); }
__device__ __forceinline__ float gelu_tanh(float x) { const float u = 1.5957691216057308f * (x + 0.044715f * x * x * x); return x * fast_sigmoid(u); }
__device__ __forceinline__ float wave_sum(float v) {
#pragma unroll
    for (int o = 1; o < 64; o <<= 1) v += __shfl_xor(v, o);
    return v;
}
#define LDS_WAIT() asm volatile("s_waitcnt lgkmcnt(0)" ::: "memory")
__device__ __forceinline__ __amdgpu_buffer_rsrc_t wt_rsrc(void* base, size_t bytes) { return __builtin_amdgcn_make_buffer_rsrc(base, 0, (int)bytes, 0x00020000); }
__device__ __forceinline__ void store16_wt(__amdgpu_buffer_rsrc_t r, size_t byte_off, u32x4 v) { __builtin_amdgcn_raw_buffer_store_b128(v, r, (unsigned)byte_off, 0, 16); }
__device__ __forceinline__ int x1b_phys_row(int r) { const int s = r & 63; return (r & ~63) + 16 * (s & 3) + (s >> 2); }
__device__ __forceinline__ int opaque_tid() { int t = threadIdx.x; asm volatile("" : "+v"(t)); return t; }

namespace pg8 {
constexpr int BM = 256, BK = 64, HALF = 128, HTB = HALF * BK * 2, STAGE_BYTES = 8 * HTB, NXCD = 8, WGM = 8;
__host__ __device__ __forceinline__ int lds_byte(int r, int c) { const int st = (r >> 4) * 2 + (c >> 5), rr = r & 15, cc = c & 31, ob = rr * 64 + cc * 2; return st * 1024 + (ob ^ (((ob >> 9) & 1) << 5)); }
__host__ __device__ __forceinline__ void stage_rc(int b, int& R, int& C) { const int st = b / 1024, sb = b % 1024, swz = sb ^ (((sb >> 9) & 1) << 5); R = (st >> 1) * 16 + swz / 64; C = (st & 1) * 32 + (swz % 64) / 2; }
__host__ __device__ __forceinline__ int perm32(int rho) { const int n = rho >> 4, i = rho & 15; return 8 * (i >> 2) + 4 * n + (i & 3); }

struct Unit { int pm, pn; };
struct Gemm { const bf16_t* A; const bf16_t* Bt; int M, N, K; const bf16_t* A2; const bf16_t* Bt2; };

struct StaticOrder {
    int nM, nN, nwg, G, c;
    __host__ __device__ void init(int M, int N, int G_, int c_) { nM = M / BM; nN = N / BM; nwg = nM * nN; G = G_; c = c_; }
    __host__ __device__ bool next(int i, Unit& u) const {
        const long L = (long)i * G + c; if (L >= nwg) return false;
        int wgid = (int)L; { const int q = nwg / NXCD, r = nwg % NXCD, xcd = wgid % NXCD, off = wgid / NXCD; wgid = (xcd < r ? xcd * (q + 1) : r * (q + 1) + (xcd - r) * q) + off; }
        const int nig = WGM * nN, gid = wgid / nig, fm = gid * WGM, gsz = (nM - fm) < WGM ? (nM - fm) : WGM;
        u.pm = fm + ((wgid % nig) % gsz); u.pn = (wgid % nig) / gsz; return true;
    }
    __device__ __forceinline__ void a_ready(const Unit&) const {}
    __device__ __forceinline__ void done(const Unit&) const {}
};

#if !NAIVE_KLOOP
template <class Epi, class Sched, int NSEG = 1>
__device__ __forceinline__ void gemm_phase(LAS unsigned char* lds, const Gemm g, const Sched& S, const Epi& E) {
    const int tid = opaque_tid(), wid = __builtin_amdgcn_readfirstlane(tid >> 6), lane = tid & 63, wr = wid >> 2, wc = wid & 3, fr = lane & 15, fq = lane >> 4;
    const int K = g.K, nt = K / BK;
    unsigned voffA[2], voffB[2];
#pragma unroll
    for (int i = 0; i < 2; ++i) { int R, C; stage_rc(tid * 16 + i * 8192, R, C); const int Rb = Epi::PERM ? ((R & ~31) + perm32(R & 31)) : R;
        voffA[i] = (unsigned)(R * K + C) * 2u; voffB[i] = (unsigned)(Rb * K + C) * 2u; }
    const size_t kstep = (size_t)(BK * 2);
    const size_t hstep = (size_t)HALF * K * 2;
    const size_t tstep = 2 * hstep;
    const unsigned ldsw = (unsigned)wid * 1024u;
    const int aoff = lds_byte(wr * 64 + fr, fq * 8), boff = lds_byte(wc * 32 + fr, fq * 8);
#define PG8_SA(b, h) (((b) * 2 + (h)) * HTB)
#define PG8_SB(b, h) ((4 + (b) * 2 + (h)) * HTB)
#define PG8_STAGE(bufoff, gbase, voff) do { _Pragma("unroll") for (int _i = 0; _i < 2; ++_i) \
        __builtin_amdgcn_global_load_lds((const unsigned*)((const char*)(gbase) + (voff)[_i]), (LAS unsigned*)(lds + (bufoff) + ldsw + _i * 8192), 16, 0, 0); } while (0)
#define PG8_LDA(dst, b, h) do { _Pragma("unroll") for (int m = 0; m < 4; ++m) _Pragma("unroll") for (int k = 0; k < 2; ++k) dst[m][k] = *(const LAS bf16x8*)(lds + PG8_SA(b, h) + aoff + m * 2048 + k * 1024); } while (0)
#define PG8_LDB(dst, b, h) do { _Pragma("unroll") for (int n = 0; n < 2; ++n) _Pragma("unroll") for (int k = 0; k < 2; ++k) dst[n][k] = *(const LAS bf16x8*)(lds + PG8_SB(b, h) + boff + n * 2048 + k * 1024); } while (0)
#define PG8_MMA(ai, bj, At, Bt) do { __builtin_amdgcn_s_setprio(1); _Pragma("unroll") for (int m = 0; m < 4; ++m) _Pragma("unroll") for (int n = 0; n < 2; ++n) _Pragma("unroll") for (int k = 0; k < 2; ++k) \
        acc[ai][bj][m][n] = __builtin_amdgcn_mfma_f32_16x16x32_bf16(Bt[n][k], At[m][k], acc[ai][bj][m][n], 0, 0, 0); __builtin_amdgcn_s_setprio(0); } while (0)
#define PG8_WAIT_V(n) asm volatile("s_waitcnt vmcnt(" #n ")" ::: "memory")
#define PG8_WAIT_L(n) asm volatile("s_waitcnt lgkmcnt(" #n ")" ::: "memory")
#define PG8_BAR __builtin_amdgcn_s_barrier()
#define PG8_SCHED __builtin_amdgcn_sched_barrier(0)
    Unit cur, nxt; int ui = 0;
    if (!S.next(0, cur)) return;
    f32x4 acc[2][2][4][2];
#pragma unroll
    for (int a = 0; a < 2; ++a)
#pragma unroll
        for (int b = 0; b < 2; ++b)
#pragma unroll
            for (int m = 0; m < 4; ++m)
#pragma unroll
                for (int n = 0; n < 2; ++n) acc[a][b][m][n] = (f32x4){0.f, 0.f, 0.f, 0.f};
    bf16x8 At[4][2], B0[2][2], B1[2][2];
    const char* cA = (const char*)g.A + (size_t)cur.pm * tstep; const char* cB = (const char*)g.Bt + (size_t)cur.pn * tstep;
    S.a_ready(cur);
    PG8_STAGE(PG8_SB(0, 0), cB, voffB); PG8_STAGE(PG8_SA(0, 0), cA, voffA); PG8_STAGE(PG8_SB(0, 1), cB + hstep, voffB); PG8_STAGE(PG8_SA(0, 1), cA + hstep, voffA);
    if (wr == 1) PG8_BAR;
    PG8_WAIT_V(4); PG8_BAR;
    PG8_STAGE(PG8_SB(1, 0), cB + kstep, voffB); PG8_STAGE(PG8_SA(1, 0), cA + kstep, voffA); PG8_STAGE(PG8_SB(1, 1), cB + hstep + kstep, voffB);
    PG8_WAIT_V(6); PG8_BAR;
#define PG8_KLOOP(KA_, KB_, KNA_, KNB_) \
        for (int t = 0; t < nt; t += 2) { \
            const bool last = (t == nt - 2); \
            const char* a1 = KA_ + (size_t)(t + 1) * kstep; \
            const char* a2 = last ? KNA_ : KA_ + (size_t)(t + 2) * kstep; const char* b2 = last ? KNB_ : KB_ + (size_t)(t + 2) * kstep; \
            const char* a3 = a2 + kstep; const char* b3 = b2 + kstep; \
            PG8_LDB(B0, 0, 0); PG8_SCHED; PG8_LDA(At, 0, 0); PG8_STAGE(PG8_SA(1, 1), a1 + hstep, voffA); \
            PG8_WAIT_L(8); PG8_BAR; PG8_WAIT_L(0); PG8_MMA(0, 0, At, B0); PG8_BAR; PG8_SCHED; \
            PG8_LDB(B1, 0, 1); PG8_STAGE(PG8_SB(0, 0), b2, voffB); \
            PG8_BAR; PG8_WAIT_L(0); PG8_MMA(0, 1, At, B1); PG8_BAR; \
            PG8_LDA(At, 0, 1); PG8_STAGE(PG8_SA(0, 0), a2, voffA); \
            PG8_BAR; PG8_WAIT_L(0); PG8_MMA(1, 0, At, B0); PG8_BAR; PG8_SCHED; \
            PG8_STAGE(PG8_SB(0, 1), b2 + hstep, voffB); \
            PG8_WAIT_V(6); PG8_BAR; PG8_MMA(1, 1, At, B1); PG8_BAR; \
            PG8_LDB(B0, 1, 0); PG8_SCHED; PG8_LDA(At, 1, 0); PG8_STAGE(PG8_SA(0, 1), a2 + hstep, voffA); \
            PG8_WAIT_L(8); PG8_BAR; PG8_WAIT_L(0); PG8_MMA(0, 0, At, B0); PG8_BAR; PG8_SCHED; \
            PG8_LDB(B1, 1, 1); PG8_STAGE(PG8_SB(1, 0), b3, voffB); \
            PG8_BAR; PG8_WAIT_L(0); PG8_MMA(0, 1, At, B1); PG8_BAR; \
            PG8_LDA(At, 1, 1); PG8_STAGE(PG8_SA(1, 0), a3, voffA); \
            PG8_BAR; PG8_WAIT_L(0); PG8_MMA(1, 0, At, B0); PG8_BAR; PG8_SCHED; \
            PG8_STAGE(PG8_SB(1, 1), b3 + hstep, voffB); \
            PG8_WAIT_V(6); PG8_BAR; PG8_MMA(1, 1, At, B1); PG8_BAR; \
        }
    for (;;) {
        const bool has_next = S.next(ui + 1, nxt);
        if constexpr (NSEG == 2) {
            const char* cA2 = (const char*)g.A2 + (size_t)cur.pm * tstep; const char* cB2 = (const char*)g.Bt2 + (size_t)cur.pn * tstep;
            PG8_KLOOP(cA, cB, cA2, cB2)
            { const int t2 = opaque_tid(), w2 = __builtin_amdgcn_readfirstlane(t2 >> 6), l2 = t2 & 63; E.mid(acc, cur, w2 >> 2, w2 & 3, l2 & 15, l2 >> 4); }
            const char* nA = has_next ? (const char*)g.A + (size_t)nxt.pm * tstep : cA2; const char* nB = has_next ? (const char*)g.Bt + (size_t)nxt.pn * tstep : cB2;
            PG8_KLOOP(cA2, cB2, nA, nB)
            cA = nA; cB = nB;
        } else {
            const char* nA = has_next ? (const char*)g.A + (size_t)nxt.pm * tstep : cA; const char* nB = has_next ? (const char*)g.Bt + (size_t)nxt.pn * tstep : cB;
            PG8_KLOOP(cA, cB, nA, nB)
            cA = nA; cB = nB;
        }
        if constexpr (!Epi::AFTER_DRAIN) { const int t2 = opaque_tid(), w2 = __builtin_amdgcn_readfirstlane(t2 >> 6), l2 = t2 & 63; E(acc, cur, w2 >> 2, w2 & 3, l2 & 15, l2 >> 4); }
        S.done(cur);
        if (!has_next) break;
#pragma unroll
        for (int a = 0; a < 2; ++a)
#pragma unroll
            for (int b = 0; b < 2; ++b)
#pragma unroll
                for (int m = 0; m < 4; ++m)
#pragma unroll
                    for (int n = 0; n < 2; ++n) acc[a][b][m][n] = (f32x4){0.f, 0.f, 0.f, 0.f};
        cur = nxt; ++ui;
    }
    PG8_WAIT_V(0);
    if (wr == 0) PG8_BAR;
    PG8_BAR;
    if constexpr (Epi::AFTER_DRAIN) E.fused(acc, cur, lds);
#undef PG8_KLOOP
#undef PG8_SA
#undef PG8_SB
#undef PG8_STAGE
#undef PG8_LDA
#undef PG8_LDB
#undef PG8_MMA
#undef PG8_WAIT_V
#undef PG8_WAIT_L
#undef PG8_BAR
#undef PG8_SCHED
}
#else
template <class Epi, class Sched, int NSEG = 1>
__device__ __forceinline__ void gemm_phase(LAS unsigned char* lds, const Gemm g, const Sched& S, const Epi& E) {
    const int tid = threadIdx.x, wid = tid >> 6, lane = tid & 63, wr = wid >> 2, wc = wid & 3, fr = lane & 15, fq = lane >> 4;
    const int K = g.K;
    Unit cur;
    for (int ui = 0; S.next(ui, cur); ++ui) {
        f32x4 acc[2][2][4][2];
#pragma unroll
        for (int a = 0; a < 2; ++a)
#pragma unroll
            for (int b = 0; b < 2; ++b)
#pragma unroll
                for (int m = 0; m < 4; ++m)
#pragma unroll
                    for (int n = 0; n < 2; ++n) acc[a][b][m][n] = (f32x4){0.f, 0.f, 0.f, 0.f};
        const bf16_t* Ab = g.A + (size_t)(cur.pm * BM + wr * 64 + fr) * K;
        const bf16_t* Bb = g.Bt + (size_t)(cur.pn * BM + wc * 32 + 8 * fq) * K;
        for (int k0 = 0; k0 < K; k0 += 2) {
            float a0[2][4], a1[2][4];
#pragma unroll
            for (int ai = 0; ai < 2; ++ai)
#pragma unroll
                for (int m = 0; m < 4; ++m) { const unsigned w = *(const unsigned*)(Ab + (size_t)(ai * HALF + m * 16) * K + k0); a0[ai][m] = bf_lo(w); a1[ai][m] = bf_hi(w); }
#pragma unroll
            for (int bj = 0; bj < 2; ++bj)
#pragma unroll
                for (int n = 0; n < 2; ++n)
#pragma unroll
                    for (int j = 0; j < 4; ++j) { const unsigned w = *(const unsigned*)(Bb + (size_t)(bj * HALF + 4 * n + j) * K + k0); const float b0 = bf_lo(w), b1 = bf_hi(w);
#pragma unroll
                        for (int ai = 0; ai < 2; ++ai)
#pragma unroll
                            for (int m = 0; m < 4; ++m) acc[ai][bj][m][n][j] += a0[ai][m] * b0 + a1[ai][m] * b1; }
        }
        if constexpr (Epi::AFTER_DRAIN) { __syncthreads(); E.fused(acc, cur, lds); } else E(acc, cur, wr, wc, fr, fq);
    }
    __syncthreads();
}
#endif
}
using pg8::Unit;

#define EPI_ROWS_BEGIN \
    const int row0 = u.pm * 256 + wr * 64 + fr, col0 = u.pn * 256 + wc * 32 + 8 * fq; \
    _Pragma("unroll") for (int ai = 0; ai < 2; ++ai) _Pragma("unroll") for (int m = 0; m < 4; ++m) { const int row = row0 + ai * 128 + m * 16;
#define EPI_COLS_BEGIN \
    _Pragma("unroll") for (int bj = 0; bj < 2; ++bj) { const int col = col0 + bj * 128; const f32x4 v0 = acc[ai][bj][m][0], v1 = acc[ai][bj][m][1]; \
        float v[8] = {v0[0], v0[1], v0[2], v0[3], v1[0], v1[1], v1[2], v1[3]};
#define EPI_END } }

struct EpiIn {
    static constexpr bool PERM = true, AFTER_DRAIN = false;
    bf16_t* P;
    __device__ __forceinline__ void operator()(f32x4 (&acc)[2][2][4][2], const Unit& u, int wr, int wc, int fr, int fq) const {
        const int mode = (u.pn < 20) ? 0 : 2;
        const __amdgpu_buffer_rsrc_t rs = wt_rsrc(P, (size_t)MTOK * NIN * 2);
        EPI_ROWS_BEGIN
        EPI_COLS_BEGIN
            if (mode == 1) {
#pragma unroll
                for (int j = 0; j < 8; ++j) v[j] = gelu_tanh(v[j]);
            } else if (mode == 2) {
#pragma unroll
                for (int j = 0; j < 8; ++j) v[j] = fast_sigmoid(v[j]);
            }
            store16_wt(rs, ((size_t)row * NIN + col) * 2, pack8(v));
        EPI_END
    }
};
struct EpiMix {
    static constexpr bool PERM = true, AFTER_DRAIN = false;
    const bf16_t* P; bf16_t* MRG;
    __device__ __forceinline__ void mid(f32x4 (&acc)[2][2][4][2], const Unit& u, int wr, int wc, int fr, int fq) const {
        const int row0 = u.pm * 256 + wr * 64 + fr, col0 = u.pn * 256 + wc * 32 + 8 * fq;
#pragma unroll
        for (int ai = 0; ai < 2; ++ai)
#pragma unroll
            for (int m = 0; m < 4; ++m) { const int row = row0 + ai * 128 + m * 16;
#pragma unroll
                for (int bj = 0; bj < 2; ++bj) { const int col = col0 + bj * 128;
                    float gl[8], gs[8]; unpack8(*(const u32x4*)(P + (size_t)row * NIN + PC_GL + col), gl); unpack8(*(const u32x4*)(P + (size_t)row * NIN + PC_GS + col), gs);
#pragma unroll
                    for (int j = 0; j < 8; ++j) { const float rt = gl[j] * __builtin_amdgcn_rcpf(fmaxf(gs[j], 1e-30f)); if (j < 4) acc[ai][bj][m][0][j] *= rt; else acc[ai][bj][m][1][j - 4] *= rt; } }
                if (m == 3) asm volatile("" ::: "memory"); }
    }
    __device__ __forceinline__ void operator()(f32x4 (&acc)[2][2][4][2], const Unit& u, int wr, int wc, int fr, int fq) const {
        const int row0 = u.pm * 256 + wr * 64 + fr, col0 = u.pn * 256 + wc * 32 + 8 * fq;
        const __amdgpu_buffer_rsrc_t rs = wt_rsrc(MRG, (size_t)MTOK * D * 2);
#pragma unroll
        for (int ai = 0; ai < 2; ++ai) {
            u32x4 gr[4][2];
#pragma unroll
            for (int m = 0; m < 4; ++m)
#pragma unroll
                for (int bj = 0; bj < 2; ++bj) gr[m][bj] = *(const u32x4*)(P + (size_t)(row0 + ai * 128 + m * 16) * NIN + PC_GS + col0 + bj * 128);
#pragma unroll
            for (int m = 0; m < 4; ++m)
#pragma unroll
                for (int bj = 0; bj < 2; ++bj) asm volatile("" : "+v"(gr[m][bj]));
#pragma unroll
            for (int m = 0; m < 4; ++m) { const int row = row0 + ai * 128 + m * 16;
#pragma unroll
                for (int bj = 0; bj < 2; ++bj) { const int col = col0 + bj * 128; const f32x4 v0 = acc[ai][bj][m][0], v1 = acc[ai][bj][m][1];
                    float v[8] = {v0[0], v0[1], v0[2], v0[3], v1[0], v1[1], v1[2], v1[3]};
                    float gs[8]; unpack8(gr[m][bj], gs);
#pragma unroll
                    for (int j = 0; j < 8; ++j) v[j] *= fmaxf(gs[j], 1e-30f);
                    store16_wt(rs, ((size_t)row * D + col) * 2, pack8(v)); } }
            asm volatile("" ::: "memory");
        }
    }
};
struct EpiO {
    static constexpr bool PERM = true, AFTER_DRAIN = false;
    const float* X; bf16_t* X1B; float* SQ;
    __device__ __forceinline__ void operator()(f32x4 (&acc)[2][2][4][2], const Unit& u, int wr, int wc, int fr, int fq) const {
        const int row0 = u.pm * 256 + wr * 64 + fr, col0 = u.pn * 256 + wc * 32 + 8 * fq;
        const __amdgpu_buffer_rsrc_t rs = wt_rsrc(X1B, (size_t)MTOK * D * 2);
#pragma unroll
        for (int ai = 0; ai < 2; ++ai)
#pragma unroll
            for (int mp = 0; mp < 2; ++mp) {
                f32x4 xr[2][2][2];
#pragma unroll
                for (int mm = 0; mm < 2; ++mm)
#pragma unroll
                    for (int bj = 0; bj < 2; ++bj) { const float* xp = X + (size_t)(row0 + ai * 128 + (2 * mp + mm) * 16) * D + col0 + bj * 128; xr[mm][bj][0] = *(const f32x4*)xp; xr[mm][bj][1] = *(const f32x4*)(xp + 4); }
#pragma unroll
                for (int mm = 0; mm < 2; ++mm)
#pragma unroll
                    for (int bj = 0; bj < 2; ++bj) asm volatile("" : "+v"(xr[mm][bj][0]), "+v"(xr[mm][bj][1]));
#pragma unroll
                for (int mm = 0; mm < 2; ++mm) { const int m = 2 * mp + mm, row = row0 + ai * 128 + m * 16; float ss = 0.f;
#pragma unroll
                    for (int bj = 0; bj < 2; ++bj) { const int col = col0 + bj * 128;
                        const f32x4 a = acc[ai][bj][m][0] + xr[mm][bj][0], b = acc[ai][bj][m][1] + xr[mm][bj][1];
                        float v[8] = {a[0], a[1], a[2], a[3], b[0], b[1], b[2], b[3]};
#pragma unroll
                        for (int j = 0; j < 8; ++j) ss += v[j] * v[j];
                        store16_wt(rs, ((size_t)x1b_phys_row(row) * D + col) * 2, pack8(v)); }
                    ss += __shfl_xor(ss, 16); ss += __shfl_xor(ss, 32);
                    if (fq == 0) SQ[(size_t)row * 32 + u.pn * 4 + wc] = ss; }
                asm volatile("" ::: "memory");
            }
    }
};
__device__ __forceinline__ float dpp_shr1(float old, float src) { return __int_as_float(__builtin_amdgcn_update_dpp(__float_as_int(old), __float_as_int(src), 0x111, 0xf, 0xf, false)); }
__device__ __forceinline__ float dpp_shr2(float old, float src) { return __int_as_float(__builtin_amdgcn_update_dpp(__float_as_int(old), __float_as_int(src), 0x112, 0xf, 0xf, false)); }
__device__ __forceinline__ float dpp_shr1z(float src) { return __int_as_float(__builtin_amdgcn_update_dpp(0, __float_as_int(src), 0x111, 0xf, 0xf, true)); }
__device__ __forceinline__ float dpp_shr2z(float src) { return __int_as_float(__builtin_amdgcn_update_dpp(0, __float_as_int(src), 0x112, 0xf, 0xf, true)); }
__device__ __forceinline__ float dpp_ror1(float src) { return __int_as_float(__builtin_amdgcn_update_dpp(0, __float_as_int(src), 0x121, 0xf, 0xf, false)); }
__device__ __forceinline__ float dpp_ror2(float src) { return __int_as_float(__builtin_amdgcn_update_dpp(0, __float_as_int(src), 0x122, 0xf, 0xf, false)); }
struct EpiUpConv {
    static constexpr bool PERM = true, AFTER_DRAIN = false;
    const float* SQ; bf16_t* FF; const float* cw; float* HALO; LAS float* hal; int* last_pm; int* ui;
    __device__ __forceinline__ void operator()(f32x4 (&acc)[2][2][4][2], const Unit& u, int wr, int wc, int fr, int fq) const {
        const int tid = opaque_tid();
        LAS float* rsl = hal + 2048; LAS float* wl = rsl + 256 + 768 * (*ui);
        const int row0 = u.pm * 256 + wr * 64 + fr;
        const int ch0 = u.pn * 128 + wc * 32 + 8 * fq;
        if (tid < 256 && u.pm != *last_pm) {
            const f32x4* sp = (const f32x4*)(SQ + (size_t)(u.pm * 256 + tid) * 32);
            f32x4 t = sp[0];
#pragma unroll
            for (int i = 1; i < 8; ++i) t += sp[i];
            rsl[tid] = 1.0f / sqrtf(((t[0] + t[1]) + (t[2] + t[3])) * (1.0f / D) + EPS);
        }
        if (fr == 15) {
#pragma unroll
            for (int ai = 0; ai < 2; ++ai) { LAS float* h = hal + ((((2 * ai + wr) * 4 + wc) * 4 + fq) * 2) * 16;
#pragma unroll
                for (int bj = 0; bj < 2; ++bj)
#pragma unroll
                    for (int n = 0; n < 2; ++n) { *(LAS f32x4*)(h + bj * 8 + n * 4) = acc[ai][bj][2][n]; *(LAS f32x4*)(h + 16 + bj * 8 + n * 4) = acc[ai][bj][3][n]; } }
        }
        asm volatile("s_waitcnt lgkmcnt(0)" ::: "memory"); __builtin_amdgcn_s_barrier(); __builtin_amdgcn_s_barrier(); asm volatile("" ::: "memory");
        float r[2][4], rp62[2], rp63[2];
#pragma unroll
        for (int ai = 0; ai < 2; ++ai) {
            const int strip = 2 * ai + wr;
            const f32x4 rr = *(const LAS f32x4*)(rsl + 64 * strip + 4 * fr);
            r[ai][0] = rr[0]; r[ai][1] = rr[1]; r[ai][2] = rr[2]; r[ai][3] = rr[3];
            rp62[ai] = 0.f; rp63[ai] = 0.f;
            if (strip > 0) { rp62[ai] = rsl[64 * strip - 2]; rp63[ai] = rsl[64 * strip - 1]; }
        }
        if (wr == 0 && fr == 0) {
#pragma unroll
            for (int m = 0; m < 2; ++m) { float* g = HALO + (size_t)(u.pm * 4 + m) * NUP + u.pn * 256 + wc * 32 + 8 * fq;
#pragma unroll
                for (int bj = 0; bj < 2; ++bj) { *(f32x4*)(g + bj * 128) = acc[0][bj][m][0] * r[0][m]; *(f32x4*)(g + bj * 128 + 4) = acc[0][bj][m][1] * r[0][m]; } } }
        if (wr == 1 && fr == 15) {
#pragma unroll
            for (int m = 2; m < 4; ++m) { float* g = HALO + (size_t)(u.pm * 4 + m) * NUP + u.pn * 256 + wc * 32 + 8 * fq;
#pragma unroll
                for (int bj = 0; bj < 2; ++bj) { *(f32x4*)(g + bj * 128) = acc[1][bj][m][0] * r[1][m]; *(f32x4*)(g + bj * 128 + 4) = acc[1][bj][m][1] * r[1][m]; } } }
        asm volatile("" ::: "memory");
        const __amdgpu_buffer_rsrc_t ffrs = wt_rsrc(FF, (size_t)MTOK * DFF * 2);
#pragma unroll
        for (int ai = 0; ai < 2; ++ai) {
            const int strip = 2 * ai + wr;
#pragma unroll
            for (int bj = 0; bj < 2; ++bj)
#pragma unroll
                for (int n = 0; n < 2; ++n) {
                    const int tcol = bj * 128 + wc * 32 + 8 * fq + 4 * n;
                    const f32x4 w0 = *(const LAS f32x4*)(wl + tcol), w1 = *(const LAS f32x4*)(wl + 256 + tcol), w2 = *(const LAS f32x4*)(wl + 512 + tcol);
                    f32x4 q62 = {0.f, 0.f, 0.f, 0.f}, q63 = {0.f, 0.f, 0.f, 0.f};
                    if (strip > 0) { const LAS float* h = hal + ((((strip - 1) * 4 + wc) * 4 + fq) * 2) * 16 + bj * 8 + n * 4;
                        q62 = *(const LAS f32x4*)h * rp62[ai]; q63 = *(const LAS f32x4*)(h + 16) * rp63[ai]; }
                    LDS_WAIT(); __builtin_amdgcn_sched_barrier(0);
#pragma unroll
                    for (int j = 0; j < 4; ++j) {
                        const float c0 = acc[ai][bj][0][n][j] * r[ai][0], c1 = acc[ai][bj][1][n][j] * r[ai][1], c2 = acc[ai][bj][2][n][j] * r[ai][2], c3 = acc[ai][bj][3][n][j] * r[ai][3];
                        const float x3 = dpp_shr1(q63[j], c3), x2 = dpp_shr1(q62[j], c2);
                        float v0 = fmaf(w0[j], x2, fmaf(w1[j], x3, w2[j] * c0));
                        float v1 = fmaf(w0[j], x3, fmaf(w1[j], c0, w2[j] * c1));
                        float v2 = fmaf(w0[j], c0, fmaf(w1[j], c1, w2[j] * c2));
                        float v3 = fmaf(w0[j], c1, fmaf(w1[j], c2, w2[j] * c3));
                        asm volatile("" : "+v"(v0), "+v"(v1), "+v"(v2), "+v"(v3));
                        acc[ai][bj][0][n][j] = v0; acc[ai][bj][1][n][j] = v1; acc[ai][bj][2][n][j] = v2; acc[ai][bj][3][n][j] = v3;
                    }
                    asm volatile("" ::: "memory"); __builtin_amdgcn_sched_barrier(0);
                }
#pragma unroll
            for (int m = 0; m < 4; ++m) { const int row = u.pm * 256 + 64 * strip + 4 * fr + m;
                float o[8];
#pragma unroll
                for (int n = 0; n < 2; ++n)
#pragma unroll
                    for (int j = 0; j < 4; ++j) { const float g = acc[ai][0][m][n][j]; o[4 * n + j] = g * fast_sigmoid(g) * acc[ai][1][m][n][j]; }
                store16_wt(ffrs, ((size_t)row * DFF + ch0) * 2, pack8(o)); }
            asm volatile("" ::: "memory"); __builtin_amdgcn_sched_barrier(0);
        }
        *last_pm = u.pm; *ui += 1;
    }
};
__device__ __forceinline__ void ff_fixup(const float* HALO, const float* cw, bf16_t* FF, int pm) {
    if ((pm & 15) == 0) return;
    constexpr int NIT = DFF / 4;
    const int t0 = opaque_tid();
    f32x4 hg[3][4], hv[3][4], wg[3][3], wv[3][3];
#pragma unroll
    for (int q = 0; q < 3; ++q) {
        const int it = t0 + 512 * q, itc = it < NIT ? it : NIT - 1, c4 = itc * 4, pn = c4 >> 7, jj = c4 & 127, tc = pn * 256 + jj;
        const float* T0 = HALO + (size_t)((pm - 1) * 4 + 2) * NUP + tc;
        const float* H0 = HALO + (size_t)(pm * 4) * NUP + tc;
        hg[q][0] = *(const f32x4*)T0; hg[q][1] = *(const f32x4*)(T0 + NUP); hg[q][2] = *(const f32x4*)H0; hg[q][3] = *(const f32x4*)(H0 + NUP);
        hv[q][0] = *(const f32x4*)(T0 + 128); hv[q][1] = *(const f32x4*)(T0 + NUP + 128); hv[q][2] = *(const f32x4*)(H0 + 128); hv[q][3] = *(const f32x4*)(H0 + NUP + 128);
#pragma unroll
        for (int k = 0; k < 3; ++k) { wg[q][k] = *(const f32x4*)(cw + k * NUP + c4); wv[q][k] = *(const f32x4*)(cw + k * NUP + DFF + c4); }
    }
#pragma unroll
    for (int q = 0; q < 3; ++q) {
#pragma unroll
        for (int k = 0; k < 4; ++k) asm volatile("" : "+v"(hg[q][k]), "+v"(hv[q][k]));
#pragma unroll
        for (int k = 0; k < 3; ++k) asm volatile("" : "+v"(wg[q][k]), "+v"(wv[q][k]));
    }
#pragma unroll
    for (int q = 0; q < 3; ++q) {
        const int it = t0 + 512 * q;
        if (it < NIT) {
#pragma unroll
            for (int rsel = 0; rsel < 2; ++rsel) {
                float o[4];
#pragma unroll
                for (int j = 0; j < 4; ++j) { const float g = wg[q][0][j] * hg[q][rsel][j] + wg[q][1][j] * hg[q][rsel + 1][j] + wg[q][2][j] * hg[q][rsel + 2][j];
                    const float v = wv[q][0][j] * hv[q][rsel][j] + wv[q][1][j] * hv[q][rsel + 1][j] + wv[q][2][j] * hv[q][rsel + 2][j]; o[j] = g * fast_sigmoid(g) * v; }
                u32x2 w; w.x = cvt_pk_bf16(o[0], o[1]); w.y = cvt_pk_bf16(o[2], o[3]);
                *(u32x2*)(FF + (size_t)(pm * 256 + rsel) * DFF + it * 4) = w;
            }
        }
    }
}
struct EpiDnNorm {
    static constexpr bool PERM = true, AFTER_DRAIN = true;
    float* X; const bf16_t* X1B; const float* gfin; float* SQ2; unsigned* cnt;
    __device__ __forceinline__ void fused(f32x4 (&acc)[2][2][4][2], const Unit& u, LAS unsigned char* lds) const {
        const int tid = opaque_tid(), wid = __builtin_amdgcn_readfirstlane(tid >> 6), lane = tid & 63, wr = wid >> 2, wc = wid & 3, fr = lane & 15, fq = lane >> 4;
        LAS float* part = (LAS float*)lds;
        LAS float* rs = part + 1024;
        const int row0 = u.pm * 256 + wr * 64 + fr, col0 = u.pn * 256 + wc * 32 + 8 * fq;
#pragma unroll
        for (int ai = 0; ai < 2; ++ai) {
            u32x4 xr[4][2];
#pragma unroll
            for (int m = 0; m < 4; ++m)
#pragma unroll
                for (int bj = 0; bj < 2; ++bj) xr[m][bj] = *(const u32x4*)(X1B + (size_t)x1b_phys_row(row0 + ai * 128 + m * 16) * D + col0 + bj * 128);
#pragma unroll
            for (int m = 0; m < 4; ++m)
#pragma unroll
                for (int bj = 0; bj < 2; ++bj) asm volatile("" : "+v"(xr[m][bj]));
#pragma unroll
            for (int m = 0; m < 4; ++m) { float ss = 0.f;
#pragma unroll
                for (int bj = 0; bj < 2; ++bj) { float xv[8]; unpack8(xr[m][bj], xv);
                    acc[ai][bj][m][0] += (f32x4){xv[0], xv[1], xv[2], xv[3]}; acc[ai][bj][m][1] += (f32x4){xv[4], xv[5], xv[6], xv[7]};
                    const f32x4 a = acc[ai][bj][m][0], b = acc[ai][bj][m][1];
                    ss += (a[0] * a[0] + a[1] * a[1]) + (a[2] * a[2] + a[3] * a[3]) + (b[0] * b[0] + b[1] * b[1]) + (b[2] * b[2] + b[3] * b[3]); }
                ss += __shfl_xor(ss, 16); ss += __shfl_xor(ss, 32);
                if (fq == 0) part[(ai * 128 + wr * 64 + m * 16 + fr) * 4 + wc] = ss; }
        }
        __syncthreads();
        if (tid < 256) { const f32x4 q = *(const LAS f32x4*)(part + tid * 4);
            __hip_atomic_store(SQ2 + ((size_t)u.pm * 8 + u.pn) * 256 + tid, (q[0] + q[1]) + (q[2] + q[3]), __ATOMIC_RELAXED, __HIP_MEMORY_SCOPE_AGENT); }
        asm volatile("s_waitcnt vmcnt(0)" ::: "memory");
        __syncthreads();
        if (tid == 0) {
            __hip_atomic_fetch_add(cnt + 64 * u.pm, 1u, __ATOMIC_RELAXED, __HIP_MEMORY_SCOPE_AGENT);
            for (int spin = 0; spin < (1 << 24); ++spin) { if (__hip_atomic_load(cnt + 64 * u.pm, __ATOMIC_RELAXED, __HIP_MEMORY_SCOPE_AGENT) >= 8u) break; __builtin_amdgcn_s_sleep(2); }
        }
        __syncthreads();
        if (tid < 256) { float tot = 0.f;
#pragma unroll
            for (int q = 0; q < 8; ++q) tot += __hip_atomic_load(SQ2 + ((size_t)u.pm * 8 + q) * 256 + tid, __ATOMIC_RELAXED, __HIP_MEMORY_SCOPE_AGENT);
            rs[tid] = 1.0f / sqrtf(tot * (1.0f / D) + EPS); }
        __syncthreads();
        f32x4 g[2][2];
#pragma unroll
        for (int bj = 0; bj < 2; ++bj) { g[bj][0] = *(const f32x4*)(gfin + col0 + bj * 128); g[bj][1] = *(const f32x4*)(gfin + col0 + bj * 128 + 4); }
#pragma unroll
        for (int ai = 0; ai < 2; ++ai)
#pragma unroll
            for (int m = 0; m < 4; ++m) { const int rl = ai * 128 + wr * 64 + m * 16 + fr; const float r = rs[rl]; float* o = X + (size_t)(u.pm * 256 + rl) * D + col0;
#pragma unroll
                for (int bj = 0; bj < 2; ++bj) { *(f32x4*)(o + bj * 128) = acc[ai][bj][m][0] * r * g[bj][0]; *(f32x4*)(o + bj * 128 + 4) = acc[ai][bj][m][1] * r * g[bj][1]; } }
    }
};

template <bool NTOUT>
__device__ __forceinline__ void p0_item64(const float* __restrict__ W, int K, int N, bf16_t* __restrict__ WT, const float* __restrict__ gk, LAS float* scr, int kb, int nb, int out_row0, int lane) {
    const int k0 = 64 * kb, n0 = 64 * nb, kq = lane >> 4, nq = 4 * (lane & 15);
    f32x4 v[16];
#pragma unroll
    for (int i = 0; i < 16; ++i) v[i] = __builtin_nontemporal_load((const f32x4*)(W + (size_t)(k0 + 4 * i + kq) * N + n0 + nq));
    if (gk) {
#pragma unroll
        for (int i = 0; i < 16; ++i) v[i] *= gk[k0 + 4 * i + kq];
    }
#pragma unroll
    for (int i = 0; i < 16; ++i) { LAS float* d = scr + (4 * i + kq) * 65 + nq; d[0] = v[i][0]; d[1] = v[i][1]; d[2] = v[i][2]; d[3] = v[i][3]; }
    LDS_WAIT();
    const int c = lane & 7;
#pragma unroll
    for (int j = 0; j < 8; ++j) { const int n = (lane >> 3) + 8 * j; const LAS float* s = scr + (8 * c) * 65 + n;
        u32x4 o; o.x = cvt_pk_bf16(s[0 * 65], s[1 * 65]); o.y = cvt_pk_bf16(s[2 * 65], s[3 * 65]); o.z = cvt_pk_bf16(s[4 * 65], s[5 * 65]); o.w = cvt_pk_bf16(s[6 * 65], s[7 * 65]);
        if (NTOUT) __builtin_nontemporal_store(o, (u32x4*)(WT + (size_t)(out_row0 + n) * K + k0 + 8 * c)); else *(u32x4*)(WT + (size_t)(out_row0 + n) * K + k0 + 8 * c) = o; }
    LDS_WAIT();
}
template <bool UPPERM, bool NTOUT = false>
__device__ __forceinline__ void convert_matrix(const float* W, int K, int N, bf16_t* WT, const float* gk, LAS unsigned char* lds, int wk, int nworkers) {
    const int tid = opaque_tid(), lane = tid & 63, wave = tid >> 6;
    LAS float* scr = (LAS float*)(lds + wave * 16640);
    const int nblk = N / 64, items = (K / 64) * nblk;
    for (int it = wk * 8 + wave; it < items; it += nworkers * 8) {
        const int kb = it / nblk, nb = it % nblk;
        int orow = 64 * nb;
        if (UPPERM) { const int bj = nb / (DFF / 64), rem = nb % (DFF / 64); orow = 256 * (rem >> 1) + 128 * bj + 64 * (rem & 1); }
        p0_item64<NTOUT>(W, K, N, WT, gk, scr, kb, nb, orow, lane);
    }
}

__device__ __forceinline__ void phase0(const Params& p, LAS unsigned char* lds) {
    const int tid = opaque_tid(), lane = tid & 63, wave = tid >> 6;
    const int gw = blockIdx.x * 8 + wave, NGW = gridDim.x * 8;
    unsigned char* ws = p.ws;
    const float* x = p.in[0]; const float* g = p.in[1]; bf16_t* H = (bf16_t*)(ws + OFF_HREG);
    for (int m = gw * 2; m < MTOK; m += NGW * 2) {
        const f32x4* xr = (const f32x4*)(x + (size_t)m * D) + lane; const f32x4* gr = (const f32x4*)g + lane;
        f32x4 v[2][8]; float s0 = 0.f, s1 = 0.f;
#pragma unroll
        for (int j = 0; j < 8; ++j) { v[0][j] = __builtin_nontemporal_load(xr + 64 * j); v[1][j] = __builtin_nontemporal_load(xr + 512 + 64 * j); }
#pragma unroll
        for (int j = 0; j < 8; ++j) { s0 += (v[0][j][0] * v[0][j][0] + v[0][j][1] * v[0][j][1]) + (v[0][j][2] * v[0][j][2] + v[0][j][3] * v[0][j][3]);
                                      s1 += (v[1][j][0] * v[1][j][0] + v[1][j][1] * v[1][j][1]) + (v[1][j][2] * v[1][j][2] + v[1][j][3] * v[1][j][3]); }
        const float rs0 = 1.0f / sqrtf(wave_sum(s0) * (1.0f / D) + EPS), rs1 = 1.0f / sqrtf(wave_sum(s1) * (1.0f / D) + EPS);
        u32x2* o = (u32x2*)(H + (size_t)m * D) + lane;
#pragma unroll
        for (int j = 0; j < 8; ++j) { const f32x4 gg = gr[64 * j]; u32x2 w;
            w.x = cvt_pk_bf16(v[0][j][0] * rs0 * gg[0], v[0][j][1] * rs0 * gg[1]); w.y = cvt_pk_bf16(v[0][j][2] * rs0 * gg[2], v[0][j][3] * rs0 * gg[3]); o[64 * j] = w;
            w.x = cvt_pk_bf16(v[1][j][0] * rs1 * gg[0], v[1][j][1] * rs1 * gg[1]); w.y = cvt_pk_bf16(v[1][j][2] * rs1 * gg[2], v[1][j][3] * rs1 * gg[3]); o[512 + 64 * j] = w; }
    }
    if (blockIdx.x == 0 && tid < 64) ((unsigned*)(ws + OFF_CNT))[64 * tid] = 0u;
    const int G = gridDim.x, c = blockIdx.x;
    convert_matrix<false>(p.in[2], D, NIN, (bf16_t*)(ws + OFF_WINT), nullptr, lds, c, G);
}

constexpr int BP = 72;
constexpr int FP = 68;
constexpr int LRU_WAVE_LDS = 16 * BP * 2 + 2 * 16 * FP * 4;
constexpr int LRU_UNITS = NB * NH * 8;
__device__ __forceinline__ void lru_partA(const Params& p, LAS unsigned char* lds, int unit, float (&hloc)[64], float (&cumA)[64], float& Aex, float& hex, unsigned (&gpk)[32]) {
    const int tid = opaque_tid(), lane = tid & 63, wave = __builtin_amdgcn_readfirstlane(tid >> 6);
    const int bc = unit & 7, hd = (unit >> 3) & (NH - 1), b = unit >> 7;
    const int ch0 = hd * HD, tw0 = bc * 512 + wave * 64;
    LAS bf16_t* wab = (LAS bf16_t*)lds; LAS bf16_t* wxb = wab + 64 * BP;
    LAS float* totA = (LAS float*)(lds + 18432); LAS float* totH = totA + 512;
    LAS unsigned char* wl = lds + 22528 + wave * LRU_WAVE_LDS;
    LAS bf16_t* xcb = (LAS bf16_t*)wl; LAS float* us = (LAS float*)(wl + 16 * BP * 2); LAS float* as_ = us + 16 * FP;
    const bf16_t* P = (const bf16_t*)(p.ws + OFF_P);
    const float* cw = p.in[3]; const float* cb = p.in[4]; const float* wa = p.in[5]; const float* ba = p.in[6]; const float* wx = p.in[7]; const float* bx = p.in[8]; const float* lam = p.in[9];
    {
        const int e = tid * 8, i = e >> 6, j0 = e & 63;
        const float* s1 = wa + (size_t)hd * 4096 + e; const float* s2 = wx + (size_t)hd * 4096 + e;
        const f32x4 a0 = *(const f32x4*)s1, a1 = *(const f32x4*)(s1 + 4), x0 = *(const f32x4*)s2, x1 = *(const f32x4*)(s2 + 4);
        const float av[8] = {a0[0], a0[1], a0[2], a0[3], a1[0], a1[1], a1[2], a1[3]}; const float xv[8] = {x0[0], x0[1], x0[2], x0[3], x1[0], x1[1], x1[2], x1[3]};
#pragma unroll
        for (int q = 0; q < 8; ++q) { wab[(j0 + q) * BP + i] = (bf16_t)(cvt_pk_bf16(av[q], 0.f) & 0xffffu); wxb[(j0 + q) * BP + i] = (bf16_t)(cvt_pk_bf16(xv[q], 0.f) & 0xffffu); }
    }
    const int ctl = lane >> 3, c8 = (lane & 7) * 8;
    float w4[4][8], bb[8];
#pragma unroll
    for (int k = 0; k < 4; ++k) { const f32x4 q0 = *(const f32x4*)(cw + k * DL + ch0 + c8), q1 = *(const f32x4*)(cw + k * DL + ch0 + c8 + 4);
        w4[k][0] = q0[0]; w4[k][1] = q0[1]; w4[k][2] = q0[2]; w4[k][3] = q0[3]; w4[k][4] = q1[0]; w4[k][5] = q1[1]; w4[k][6] = q1[2]; w4[k][7] = q1[3]; }
    { const f32x4 q0 = *(const f32x4*)(cb + ch0 + c8), q1 = *(const f32x4*)(cb + ch0 + c8 + 4); bb[0] = q0[0]; bb[1] = q0[1]; bb[2] = q0[2]; bb[3] = q0[3]; bb[4] = q1[0]; bb[5] = q1[1]; bb[6] = q1[2]; bb[7] = q1[3]; }
    const int r16 = lane & 15, quad = lane >> 4;
    float bav[4], bxv[4], sp8[4];
#pragma unroll
    for (int ct = 0; ct < 4; ++ct) { const int ch = ch0 + 16 * ct + r16; bav[ct] = ba[ch]; bxv[ct] = bx[ch]; sp8[ct] = -8.0f * log1pf(__expf(-lam[ch])); }
    __syncthreads();
    float h = 0.f, A = 1.f;
#pragma unroll
    for (int sc = 0; sc < 4; ++sc) {
        const int ts0 = tw0 + 16 * sc;
#pragma unroll
        for (int ps = 0; ps < 2; ++ps) {
            const int tl = ps * 8 + ctl;
            float xc[8];
#pragma unroll
            for (int j = 0; j < 8; ++j) xc[j] = bb[j];
#pragma unroll
            for (int k = 0; k < 4; ++k) {
                const int tt = ts0 + tl - 3 + k;
                if (tt >= 0) { float xin[8]; unpack8(*(const u32x4*)(P + (size_t)(b * SEQ + tt) * NIN + PC_LX + ch0 + c8), xin);
#pragma unroll
                    for (int j = 0; j < 8; ++j) xc[j] += w4[k][j] * xin[j]; }
            }
            *(LAS f32x4*)(us + tl * FP + c8) = (f32x4){xc[0], xc[1], xc[2], xc[3]}; *(LAS f32x4*)(us + tl * FP + c8 + 4) = (f32x4){xc[4], xc[5], xc[6], xc[7]};
            *(LAS u32x4*)(xcb + tl * BP + c8) = pack8(xc);
        }
        LDS_WAIT();
        {
            bf16x8 af[2];
#pragma unroll
            for (int kk = 0; kk < 2; ++kk) af[kk] = *(const LAS bf16x8*)(xcb + r16 * BP + kk * 32 + quad * 8);
#pragma unroll
            for (int ct = 0; ct < 4; ++ct) {
                f32x4 ar = {0.f, 0.f, 0.f, 0.f}, ai = {0.f, 0.f, 0.f, 0.f};
#pragma unroll
                for (int kk = 0; kk < 2; ++kk) {
                    const bf16x8 b1 = *(const LAS bf16x8*)(wab + (16 * ct + r16) * BP + kk * 32 + quad * 8);
                    const bf16x8 b2 = *(const LAS bf16x8*)(wxb + (16 * ct + r16) * BP + kk * 32 + quad * 8);
                    ar = __builtin_amdgcn_mfma_f32_16x16x32_bf16(af[kk], b1, ar, 0, 0, 0);
                    ai = __builtin_amdgcn_mfma_f32_16x16x32_bf16(af[kk], b2, ai, 0, 0, 0);
                }
                const int j = 16 * ct + r16;
#pragma unroll
                for (int rg = 0; rg < 4; ++rg) {
                    const int t = quad * 4 + rg;
                    const float r = fast_sigmoid(ar[rg] + bav[ct]), ig = fast_sigmoid(ai[rg] + bxv[ct]);
                    const float a = __builtin_amdgcn_exp2f(1.4426950408889634f * (sp8[ct] * r)), mult = sqrtf(fmaxf(fmaf(-a, a, 1.0f), 0.f));
                    const float xc = us[t * FP + j];
                    us[t * FP + j] = mult * (ig * xc); as_[t * FP + j] = a;
                }
            }
        }
        LDS_WAIT();
#pragma unroll
        for (int s = 0; s < 16; ++s) { const float a = as_[s * FP + lane], uu = us[s * FP + lane]; h = a * h + uu; A *= a; hloc[sc * 16 + s] = h; cumA[sc * 16 + s] = A; }
        LDS_WAIT();
    }
    totA[wave * 64 + lane] = A; totH[wave * 64 + lane] = h;
    {
        const bf16_t* G = P + (size_t)(b * SEQ + tw0) * NIN + PC_LG + ch0 + lane;
#pragma unroll
        for (int s2 = 0; s2 < 32; ++s2) gpk[s2] = (unsigned)G[(size_t)(2 * s2) * NIN] | ((unsigned)G[(size_t)(2 * s2 + 1) * NIN] << 16);
    }
    __syncthreads();
    Aex = 1.f; hex = 0.f;
    for (int w = 0; w < wave; ++w) { const float a = totA[w * 64 + lane], hh = totH[w * 64 + lane]; hex = a * hex + hh; Aex *= a; }
    if (wave == 7) {
        const size_t o = (size_t)(b * 8 + bc) * DL + ch0 + lane;
        __hip_atomic_store((float*)(p.ws + OFF_LA) + o, Aex * A, __ATOMIC_RELAXED, __HIP_MEMORY_SCOPE_AGENT);
        __hip_atomic_store((float*)(p.ws + OFF_LH) + o, A * hex + h, __ATOMIC_RELAXED, __HIP_MEMORY_SCOPE_AGENT);
        asm volatile("s_waitcnt vmcnt(0)" ::: "memory");
        if (lane == 0) __hip_atomic_fetch_add((unsigned*)(p.ws + OFF_CNT) + 64 * (32 + b * NH + hd), 1u, __ATOMIC_RELAXED, __HIP_MEMORY_SCOPE_AGENT);
    }
}
__device__ __forceinline__ void lru_partB(const Params& p, int unit, const float (&hloc)[64], const float (&cumA)[64], float Aex, float hex, const unsigned (&gpk)[32]) {
    const int tid = opaque_tid(), lane = tid & 63, wave = __builtin_amdgcn_readfirstlane(tid >> 6);
    const int bc = unit & 7, hd = (unit >> 3) & (NH - 1), b = unit >> 7;
    const int ch0 = hd * HD, tw0 = bc * 512 + wave * 64;
    const float* LA = (const float*)(p.ws + OFF_LA); const float* LH = (const float*)(p.ws + OFF_LH);
    if (bc > 0) {
        if (tid == 0) { unsigned* cn = (unsigned*)(p.ws + OFF_CNT) + 64 * (32 + b * NH + hd);
            for (int spin = 0; spin < (1 << 24); ++spin) { if (__hip_atomic_load(cn, __ATOMIC_RELAXED, __HIP_MEMORY_SCOPE_AGENT) >= 8u) break; __builtin_amdgcn_s_sleep(1); } }
        __syncthreads();
    }
    float hin = 0.f;
    for (int c2 = 0; c2 < bc; ++c2) { const size_t o = (size_t)(b * 8 + c2) * DL + ch0 + lane;
        hin = __hip_atomic_load((float*)LA + o, __ATOMIC_RELAXED, __HIP_MEMORY_SCOPE_AGENT) * hin + __hip_atomic_load((float*)LH + o, __ATOMIC_RELAXED, __HIP_MEMORY_SCOPE_AGENT); }
    const float hw = Aex * hin + hex;
    bf16_t* O = (bf16_t*)(p.ws + OFF_HREG) + (size_t)(b * SEQ + tw0) * DL + ch0 + lane;
#pragma unroll
    for (int s = 0; s < 64; ++s) { const float gt = gelu_tanh((s & 1) ? bf_hi(gpk[s >> 1]) : bf_lo(gpk[s >> 1]));
        O[(size_t)s * DL] = (bf16_t)(cvt_pk_bf16((hloc[s] + cumA[s] * hw) * gt, 0.f) & 0xffffu); }
}

__device__ __forceinline__ void sc_item_load(const bf16_t* P, int it, u32x4 (&cv)[3], u32x4 (&vv)[3], u32x4& bv) {
    const int row = it / (DS / 8), c8 = (it % (DS / 8)) * 8, t = row % SEQ;
#pragma unroll
    for (int k = 0; k < 3; ++k) {
        const int rr = (t - 2 + k >= 0) ? (row - 2 + k) : row;
        const bf16_t* pr = P + (size_t)rr * NIN + c8;
        cv[k] = *(const u32x4*)(pr + PC_SC); vv[k] = *(const u32x4*)(pr + PC_SV);
    }
    bv = *(const u32x4*)(P + (size_t)row * NIN + PC_SB + c8);
}
__device__ __forceinline__ void sc_item_finish(const float* cw, bf16_t* ASC, int it, const u32x4 (&cv)[3], const u32x4 (&vv)[3], const u32x4& bv) {
    const int row = it / (DS / 8), c8 = (it % (DS / 8)) * 8, t = row % SEQ;
    float acc[8] = {0.f, 0.f, 0.f, 0.f, 0.f, 0.f, 0.f, 0.f};
#pragma unroll
    for (int k = 0; k < 3; ++k) {
        float c[8], v[8]; unpack8(cv[k], c); unpack8(vv[k], v);
        const f32x4 w0 = *(const f32x4*)(cw + k * DS + c8), w1 = *(const f32x4*)(cw + k * DS + c8 + 4);
        const float wv[8] = {w0[0], w0[1], w0[2], w0[3], w1[0], w1[1], w1[2], w1[3]};
        const float msk = (t - 2 + k >= 0) ? 1.0f : 0.0f;
#pragma unroll
        for (int j = 0; j < 8; ++j) acc[j] += (msk * wv[j]) * (c[j] * v[j]);
    }
    float b[8]; unpack8(bv, b);
#pragma unroll
    for (int j = 0; j < 8; ++j) acc[j] *= b[j];
    *(u32x4*)(ASC + (size_t)row * DS + c8) = pack8(acc);
}
__device__ __forceinline__ void sc_phase(const Params& p) {
    const bf16_t* P = (const bf16_t*)(p.ws + OFF_P);
    bf16_t* ASC = (bf16_t*)(p.ws + OFF_HREG) + (size_t)MTOK * DL;
    const float* cw = p.in[11];
    const int nth = gridDim.x * 512, NIT = MTOK * (DS / 8);
    for (int it = blockIdx.x * 512 + opaque_tid(); it < NIT; it += 4 * nth) {
        u32x4 cv[4][3], vv[4][3], bv[4];
#pragma unroll
        for (int q = 0; q < 4; ++q) if (it + q * nth < NIT) sc_item_load(P, it + q * nth, cv[q], vv[q], bv[q]);
#pragma unroll
        for (int q = 0; q < 4; ++q) if (it + q * nth < NIT) sc_item_finish(cw, ASC, it + q * nth, cv[q], vv[q], bv[q]);
    }
}

__device__ __forceinline__ void final_norm_phase(const Params& p) {
    const int tid = opaque_tid(), lane = tid & 63, wave = tid >> 6;
    const int gw = blockIdx.x * 8 + wave, NGW = gridDim.x * 8;
    const float* g = p.in[18];
    for (int m = gw; m < MTOK; m += NGW) {
        f32x4* xr = (f32x4*)(p.out + (size_t)m * D) + lane; const f32x4* gr = (const f32x4*)g + lane;
        f32x4 v[8]; float s = 0.f;
#pragma unroll
        for (int j = 0; j < 8; ++j) { v[j] = xr[64 * j]; s += (v[j][0] * v[j][0] + v[j][1] * v[j][1]) + (v[j][2] * v[j][2] + v[j][3] * v[j][3]); }
        const float rstd = 1.0f / sqrtf(wave_sum(s) * (1.0f / D) + EPS);
#pragma unroll
        for (int j = 0; j < 8; ++j) { const f32x4 gg = gr[64 * j]; xr[64 * j] = (f32x4){v[j][0] * rstd * gg[0], v[j][1] * rstd * gg[1], v[j][2] * rstd * gg[2], v[j][3] * rstd * gg[3]}; }
    }
}

#define XB_TMO      128
#define XB_XCNT(j)  (256  + 64 * (j))
#define XB_XSUB(j)  (1280 + 64 * (j))
#define XB_XGEN(j)  (2304 + 64 * (j))
#define XB_TOP      3328
#define XB_TOPGEN   3392
#define XCD_BAR_WORDS 3456
#define XB_SPIN_CAP (1u << 18)

__device__ __forceinline__ unsigned xb_ld(unsigned* p)              { return __hip_atomic_load(p, __ATOMIC_RELAXED, __HIP_MEMORY_SCOPE_AGENT); }
__device__ __forceinline__ unsigned xb_add(unsigned* p, unsigned v) { return __hip_atomic_fetch_add(p, v, __ATOMIC_RELAXED, __HIP_MEMORY_SCOPE_AGENT); }
__device__ __forceinline__ unsigned xb_xcc_id() { return (unsigned)__builtin_amdgcn_s_getreg((3 << 11) | 20) & 0xFu; }
#define XB_SPIN(cond, bar) do { unsigned _sp = 0; while (cond) { __builtin_amdgcn_s_sleep(1); \
    if ((++_sp & 255u) == 0u) { if (xb_ld(&(bar)[XB_TMO])) break; if (_sp > XB_SPIN_CAP) { atomicAdd(&(bar)[XB_TMO], 1u); break; } } } } while (0)

struct XcdBarrier {
    unsigned* bar; unsigned x;
    volatile LAS unsigned* st;
};

__device__ __forceinline__ XcdBarrier xcd_barrier_post(unsigned* bar, volatile LAS unsigned* st) {
    XcdBarrier b; b.bar = bar; b.x = xb_xcc_id(); b.st = st;
    if (threadIdx.x == 0) (void)xb_add(&bar[XB_XCNT(b.x)], 1u);
    return b;
}
__device__ __forceinline__ void xcd_barrier_complete(unsigned* bar, unsigned x, unsigned& nloc, unsigned& nx) {
    const unsigned G = gridDim.x * gridDim.y * gridDim.z;
    unsigned sum, cnt, mine, sp = 0u;
    for (;;) {
        sum = 0u; cnt = 0u; mine = 0u;
#pragma unroll
        for (unsigned j = 0; j < 16; ++j) { const unsigned c = xb_ld(&bar[XB_XCNT(j)]); sum += c; cnt += (c > 0u) ? 1u : 0u; mine = (j == x) ? c : mine; }
        if (sum == G) break;
        __builtin_amdgcn_s_sleep(1);
        if ((++sp & 255u) == 0u) { if (xb_ld(&bar[XB_TMO])) break; if (sp > XB_SPIN_CAP) { atomicAdd(&bar[XB_TMO], 1u); break; } }
    }
    nloc = mine > 0u ? mine : 1u; nx = cnt > 0u ? cnt : 1u;
}

__device__ __forceinline__ void xcd_barrier(const XcdBarrier& b) {
    asm volatile("s_waitcnt vmcnt(0)" ::: "memory");
    __syncthreads();
    if (threadIdx.x == 0) {
        unsigned* bar = b.bar;
        __builtin_amdgcn_s_waitcnt(0);
        unsigned nloc = b.st[0], nx = b.st[1];
        if (nloc == 0u) { xcd_barrier_complete(bar, b.x, nloc, nx); b.st[0] = nloc; b.st[1] = nx; }
        const unsigned old = xb_add(&bar[XB_XSUB(b.x)], 1u);
        const unsigned gen = old / nloc;
        if (old + 1u == (gen + 1u) * nloc) {
            __builtin_amdgcn_fence(__ATOMIC_RELEASE, "agent");
            asm volatile("s_waitcnt vmcnt(0)" ::: "memory");
            const unsigned og = xb_add(&bar[XB_TOP], 1u);
            const unsigned tg = og / nx;
            if (og + 1u == (tg + 1u) * nx) xb_add(&bar[XB_TOPGEN], 1u);
            else XB_SPIN(xb_ld(&bar[XB_TOPGEN]) == tg, bar);
            __builtin_amdgcn_fence(__ATOMIC_ACQUIRE, "agent");
            xb_add(&bar[XB_XGEN(b.x)], 1u);
            asm volatile("s_waitcnt vmcnt(0)" ::: "memory");
        } else {
            XB_SPIN(xb_ld(&bar[XB_XGEN(b.x)]) == gen, bar);
            __builtin_amdgcn_fence(__ATOMIC_ACQUIRE, "agent");
            asm volatile("s_waitcnt vmcnt(0)" ::: "memory");
        }
    }
    __syncthreads();
}


__global__ void __launch_bounds__(512, 2) mega_fwd(Params p) {
    extern __shared__ __attribute__((aligned(16))) unsigned char lds_raw[];
    LAS unsigned char* lds = (LAS unsigned char*)lds_raw;
    unsigned char* ws = p.ws;
    const int G = gridDim.x, c = blockIdx.x;
    LAS unsigned* stw = (LAS unsigned*)(lds + LDS_BYTES - 16);
    if (threadIdx.x < 4) stw[threadIdx.x] = 0u;
    __syncthreads();
    const XcdBarrier xb = xcd_barrier_post((unsigned*)(ws + OFF_BAR), (volatile LAS unsigned*)stw);

    phase0(p, lds);
    xcd_barrier(xb);
    {
        pg8::Gemm g{(const bf16_t*)(ws + OFF_HREG), (const bf16_t*)(ws + OFF_WINT), MTOK, NIN, D, nullptr, nullptr}; pg8::StaticOrder S; S.init(MTOK, NIN, G, c);
        EpiIn E{(bf16_t*)(ws + OFF_P)};
        pg8::gemm_phase<EpiIn, pg8::StaticOrder>(lds, g, S, E);
        const int rem = S.nwg % G;
        if (rem == 0 || c >= rem) {
            const int wk = rem ? c - rem : c, nwk = rem ? G - rem : G;
            convert_matrix<false, true>(p.in[10], DL, D, (bf16_t*)(ws + OFF_WLRU), nullptr, lds, wk, nwk);
            convert_matrix<false, true>(p.in[12], DS, D, (bf16_t*)(ws + OFF_WSC), nullptr, lds, wk, nwk);
            convert_matrix<false, true>(p.in[13], D, D, (bf16_t*)(ws + OFF_WO), nullptr, lds, wk, nwk);
            convert_matrix<true, true>(p.in[15], D, NUP, (bf16_t*)(ws + OFF_WUP), p.in[14], lds, wk, nwk);
        }
    }
    xcd_barrier(xb);
    sc_phase(p);
    {
        float hloc[64], cumA[64], Aex = 1.f, hex = 0.f; unsigned gpk[32];
        const bool has_unit = c < LRU_UNITS;
        if (has_unit) { lru_partA(p, lds, c, hloc, cumA, Aex, hex, gpk); lru_partB(p, c, hloc, cumA, Aex, hex, gpk); }
    }
    xcd_barrier(xb);
    {
        pg8::StaticOrder S; S.init(MTOK, D, G, c);
        pg8::Gemm g{(const bf16_t*)(ws + OFF_HREG), (const bf16_t*)(ws + OFF_WLRU), MTOK, D, DL, (const bf16_t*)(ws + OFF_HREG) + (size_t)MTOK * DL, (const bf16_t*)(ws + OFF_WSC)};
        EpiMix E{(const bf16_t*)(ws + OFF_P), (bf16_t*)(ws + OFF_MRG)};
        pg8::gemm_phase<EpiMix, pg8::StaticOrder, 2>(lds, g, S, E);
    }
    xcd_barrier(xb);
    {
        pg8::Gemm g{(const bf16_t*)(ws + OFF_MRG), (const bf16_t*)(ws + OFF_WO), MTOK, D, D, nullptr, nullptr}; pg8::StaticOrder S; S.init(MTOK, D, G, c);
        EpiO E{p.in[0], (bf16_t*)(ws + OFF_HREG), (float*)(ws + OFF_SQ)};
        pg8::gemm_phase<EpiO, pg8::StaticOrder>(lds, g, S, E);
    }
    xcd_barrier(xb);
    {
        pg8::Gemm g{(const bf16_t*)(ws + OFF_HREG), (const bf16_t*)(ws + OFF_WUP), MTOK, NUP, D, nullptr, nullptr}; pg8::StaticOrder S; S.init(MTOK, NUP, G, c);
        int last_pm = -1, epi_ui = 0;
        {
            LAS float* wl0 = (LAS float*)(lds + pg8::STAGE_BYTES) + 2048 + 256;
            Unit uu; const int t0 = opaque_tid();
            for (int i = 0; i < 6 && S.next(i, uu); ++i)
                if (t0 < 192) { const int k = t0 >> 6, q = t0 & 63, bj = q >> 5;
                    *(LAS f32x4*)(wl0 + 768 * i + k * 256 + 4 * q) = *(const f32x4*)(p.in[16] + k * NUP + bj * DFF + uu.pn * 128 + ((4 * q) & 127)); }
            __syncthreads();
        }
        EpiUpConv E{(const float*)(ws + OFF_SQ), (bf16_t*)(ws + OFF_FF), p.in[16], (float*)(ws + OFF_HALO), (LAS float*)(lds + pg8::STAGE_BYTES), &last_pm, &epi_ui};
        pg8::gemm_phase<EpiUpConv, pg8::StaticOrder>(lds, g, S, E);
        const int rem = S.nwg % G;
        if (rem == 0) convert_matrix<false, true>(p.in[17], DFF, D, (bf16_t*)(ws + OFF_WDN), nullptr, lds, c, G);
        else if (c >= rem) convert_matrix<false, true>(p.in[17], DFF, D, (bf16_t*)(ws + OFF_WDN), nullptr, lds, c - rem, G - rem);
    }
    xcd_barrier(xb);
    {
        pg8::Gemm g{(const bf16_t*)(ws + OFF_FF), (const bf16_t*)(ws + OFF_WDN), MTOK, D, DFF, nullptr, nullptr}; pg8::StaticOrder S; S.init(MTOK, D, G, c);
        { Unit u; for (int ui = 0; S.next(ui, u); ++ui) ff_fixup((const float*)(ws + OFF_HALO), p.in[16], (bf16_t*)(ws + OFF_FF), u.pm);
          asm volatile("s_waitcnt vmcnt(0)" ::: "memory"); __syncthreads(); }
        EpiDnNorm E{p.out, (const bf16_t*)(ws + OFF_HREG), p.in[18], (float*)(ws + OFF_SQ2), (unsigned*)(ws + OFF_CNT)};
        pg8::gemm_phase<EpiDnNorm, pg8::StaticOrder>(lds, g, S, E);
    }
}

extern "C" void kernel_launch(void* const* d_in, const int* in_sizes, int n_in, void* d_out, int out_size, void* d_ws, size_t ws_size, hipStream_t stream) {
    static int grid_blocks = 0;
    if (grid_blocks == 0) {
        if (n_in != 19 || out_size != MTOK * D || ws_size < WS_END) { fprintf(stderr, "kernel_launch: unexpected shapes (n_in %d out %d ws %zu, need %zu)\n", n_in, out_size, ws_size, (size_t)WS_END); grid_blocks = -1; return; }
        int dev = 0, cus = 0, per_cu = 0;
        (void)hipGetDevice(&dev);
        (void)hipDeviceGetAttribute(&cus, hipDeviceAttributeMultiprocessorCount, dev);
        (void)hipFuncSetAttribute((const void*)mega_fwd, hipFuncAttributeMaxDynamicSharedMemorySize, LDS_BYTES);
        (void)hipOccupancyMaxActiveBlocksPerMultiprocessor(&per_cu, (const void*)mega_fwd, 512, LDS_BYTES);
        if (per_cu < 1) { fprintf(stderr, "kernel_launch: occupancy query says %d blocks/CU: nothing launched\n", per_cu); grid_blocks = -1; return; }
        if (cus < LRU_UNITS) { fprintf(stderr, "kernel_launch: needs >= %d CUs (got %d)\n", LRU_UNITS, cus); grid_blocks = -1; return; }
        grid_blocks = cus * (per_cu < 1 ? per_cu : 1);
    }
    if (grid_blocks < 0) return;
    Params p{};
    for (int i = 0; i < 19; ++i) p.in[i] = (const float*)d_in[i];
    p.out = (float*)d_out; p.ws = (unsigned char*)d_ws;
    (void)hipMemsetAsync((char*)d_ws + OFF_BAR, 0, XCD_BAR_WORDS * 4, stream);
    void* args[] = {&p};
    hipError_t e = hipLaunchCooperativeKernel((const void*)mega_fwd, dim3(grid_blocks), dim3(512), args, LDS_BYTES, stream);
    if (e != hipSuccess) fprintf(stderr, "cooperative launch failed: %s (grid %d)\n", hipGetErrorString(e), grid_blocks);
}
```

```cpp
#include <hip/hip_runtime.h>
#include <cstdio>

#ifndef NAIVE_KLOOP
#define NAIVE_KLOOP 0
#endif

#define LAS __attribute__((address_space(3)))
typedef unsigned short bf16_t;
typedef short bf16x8 __attribute__((ext_vector_type(8)));
typedef float f32x4 __attribute__((ext_vector_type(4)));
typedef float f32x2 __attribute__((ext_vector_type(2)));
typedef unsigned u32x4 __attribute__((ext_vector_type(4)));
typedef unsigned u32x2 __attribute__((ext_vector_type(2)));

constexpr int SEQ = 4096, NB = 2, MTOK = NB * SEQ;
constexpr int D = 2048, DL = 1024, DS = 1024, DFF = 5632, NUP = 2 * DFF, NIN = 2 * DL + 3 * DS + 2 * D;
constexpr int NH = 16, HD = 64;
constexpr float EPS = 1e-6f;
constexpr int PC_LX = 0, PC_LG = 1024, PC_SB = 2048, PC_SC = 3072, PC_SV = 4096, PC_GL = 5120, PC_GS = 7168;
constexpr int LNCH = 8;

constexpr size_t OFF_WINT = 0;
constexpr size_t OFF_WLRU = OFF_WINT + (size_t)NIN * D * 2;
constexpr size_t OFF_WSC  = OFF_WLRU + (size_t)D * DL * 2;
constexpr size_t OFF_WO   = OFF_WSC + (size_t)D * DS * 2;
constexpr size_t OFF_HREG = OFF_WO + (size_t)D * D * 2;
constexpr size_t OFF_WUP  = (size_t)MTOK * DFF * 2;
constexpr size_t OFF_WDN  = OFF_WUP + (size_t)NUP * D * 2;
constexpr size_t OFF_P    = OFF_WDN + (size_t)D * DFF * 2;
constexpr size_t OFF_MRG  = OFF_P + (size_t)MTOK * NIN * 2;
constexpr size_t OFF_FF   = OFF_P;
constexpr size_t OFF_SQ   = OFF_MRG + (size_t)MTOK * D * 2;
constexpr size_t OFF_LA   = OFF_SQ + (size_t)MTOK * 32 * 4;
constexpr size_t OFF_LH   = OFF_LA + (size_t)NB * LNCH * DL * 4;
constexpr size_t OFF_HALO = OFF_LH + (size_t)NB * LNCH * DL * 4;
constexpr size_t OFF_SQ2  = OFF_HALO + (size_t)(MTOK / 256) * 4 * NUP * 4;
constexpr size_t OFF_CNT  = OFF_SQ2 + (size_t)(MTOK / 256) * 8 * 256 * 4;
constexpr size_t OFF_BAR  = OFF_CNT + (size_t)64 * 256;
constexpr size_t WS_END   = OFF_BAR + 3456 * 4;
static_assert(OFF_HREG + (size_t)MTOK * D * 2 <= OFF_WUP, "ws overlap");

constexpr int LDS_BYTES = 160 * 1024;

struct Params { const float* in[19]; float* out; unsigned char* ws; };

__device__ __forceinline__ unsigned cvt_pk_bf16(float lo, float hi) { unsigned r; asm volatile("v_cvt_pk_bf16_f32 %0, %1, %2" : "=v"(r) : "v"(lo), "v"(hi)); return r; }
__device__ __forceinline__ float bf_lo(unsigned w) { return __uint_as_float(w << 16); }
__device__ __forceinline__ float bf_hi(unsigned w) { return __uint_as_float(w & 0xffff0000u); }
__device__ __forceinline__ void unpack8(const u32x4 w, float (&f)[8]) {
    f[0] = bf_lo(w.x); f[1] = bf_hi(w.x); f[2] = bf_lo(w.y); f[3] = bf_hi(w.y); f[4] = bf_lo(w.z); f[5] = bf_hi(w.z); f[6] = bf_lo(w.w); f[7] = bf_hi(w.w);
}
__device__ __forceinline__ u32x4 pack8(const float (&f)[8]) { u32x4 o; o.x = cvt_pk_bf16(f[0], f[1]); o.y = cvt_pk_bf16(f[2], f[3]); o.z = cvt_pk_bf16(f[4], f[5]); o.w = cvt_pk_bf16(f[6], f[7]); return o; }
__device__ __forceinline__ float fast_sigmoid(float x) { return __builtin_amdgcn_rcpf(1.0f + __builtin_amdgcn_exp2f(-1.4426950408889634f * x)); }
__device__ __forceinline__ float gelu_tanh(float x) { const float u = 1.5957691216057308f * (x + 0.044715f * x * x * x); return x * fast_sigmoid(u); }
__device__ __forceinline__ float wave_sum(float v) {
#pragma unroll
    for (int o = 1; o < 64; o <<= 1) v += __shfl_xor(v, o);
    return v;
}
#define LDS_WAIT() asm volatile("s_waitcnt lgkmcnt(0)" ::: "memory")
__device__ __forceinline__ __amdgpu_buffer_rsrc_t wt_rsrc(void* base, size_t bytes) { return __builtin_amdgcn_make_buffer_rsrc(base, 0, (int)bytes, 0x00020000); }
__device__ __forceinline__ void store16_wt(__amdgpu_buffer_rsrc_t r, size_t byte_off, u32x4 v) { __builtin_amdgcn_raw_buffer_store_b128(v, r, (unsigned)byte_off, 0, 16); }
__device__ __forceinline__ int x1b_phys_row(int r) { const int s = r & 63; return (r & ~63) + 16 * (s & 3) + (s >> 2); }
__device__ __forceinline__ int opaque_tid() { int t = threadIdx.x; asm volatile("" : "+v"(t)); return t; }

namespace pg8 {
constexpr int BM = 256, BK = 64, HALF = 128, HTB = HALF * BK * 2, STAGE_BYTES = 8 * HTB, NXCD = 8, WGM = 8;
__host__ __device__ __forceinline__ int lds_byte(int r, int c) { const int st = (r >> 4) * 2 + (c >> 5), rr = r & 15, cc = c & 31, ob = rr * 64 + cc * 2; return st * 1024 + (ob ^ (((ob >> 9) & 1) << 5)); }
__host__ __device__ __forceinline__ void stage_rc(int b, int& R, int& C) { const int st = b / 1024, sb = b % 1024, swz = sb ^ (((sb >> 9) & 1) << 5); R = (st >> 1) * 16 + swz / 64; C = (st & 1) * 32 + (swz % 64) / 2; }
__host__ __device__ __forceinline__ int perm32(int rho) { const int n = rho >> 4, i = rho & 15; return 8 * (i >> 2) + 4 * n + (i & 3); }

struct Unit { int pm, pn; };
struct Gemm { const bf16_t* A; const bf16_t* Bt; int M, N, K; const bf16_t* A2; const bf16_t* Bt2; };

struct StaticOrder {
    int nM, nN, nwg, G, c;
    __host__ __device__ void init(int M, int N, int G_, int c_) { nM = M / BM; nN = N / BM; nwg = nM * nN; G = G_; c = c_; }
    __host__ __device__ bool next(int i, Unit& u) const {
        const long L = (long)i * G + c; if (L >= nwg) return false;
        int wgid = (int)L; { const int q = nwg / NXCD, r = nwg % NXCD, xcd = wgid % NXCD, off = wgid / NXCD; wgid = (xcd < r ? xcd * (q + 1) : r * (q + 1) + (xcd - r) * q) + off; }
        const int nig = WGM * nN, gid = wgid / nig, fm = gid * WGM, gsz = (nM - fm) < WGM ? (nM - fm) : WGM;
        u.pm = fm + ((wgid % nig) % gsz); u.pn = (wgid % nig) / gsz; return true;
    }
    __device__ __forceinline__ void a_ready(const Unit&) const {}
    __device__ __forceinline__ void done(const Unit&) const {}
};

#if !NAIVE_KLOOP
template <class Epi, class Sched, int NSEG = 1>
__device__ __forceinline__ void gemm_phase(LAS unsigned char* lds, const Gemm g, const Sched& S, const Epi& E) {
    const int tid = opaque_tid(), wid = __builtin_amdgcn_readfirstlane(tid >> 6), lane = tid & 63, wr = wid >> 2, wc = wid & 3, fr = lane & 15, fq = lane >> 4;
    const int K = g.K, nt = K / BK;
    unsigned voffA[2], voffB[2];
#pragma unroll
    for (int i = 0; i < 2; ++i) { int R, C; stage_rc(tid * 16 + i * 8192, R, C); const int Rb = Epi::PERM ? ((R & ~31) + perm32(R & 31)) : R;
        voffA[i] = (unsigned)(R * K + C) * 2u; voffB[i] = (unsigned)(Rb * K + C) * 2u; }
    const size_t kstep = (size_t)(BK * 2);
    const size_t hstep = (size_t)HALF * K * 2;
    const size_t tstep = 2 * hstep;
    const unsigned ldsw = (unsigned)wid * 1024u;
    const int aoff = lds_byte(wr * 64 + fr, fq * 8), boff = lds_byte(wc * 32 + fr, fq * 8);
#define PG8_SA(b, h) (((b) * 2 + (h)) * HTB)
#define PG8_SB(b, h) ((4 + (b) * 2 + (h)) * HTB)
#define PG8_STAGE(bufoff, gbase, voff) do { _Pragma("unroll") for (int _i = 0; _i < 2; ++_i) \
        __builtin_amdgcn_global_load_lds((const unsigned*)((const char*)(gbase) + (voff)[_i]), (LAS unsigned*)(lds + (bufoff) + ldsw + _i * 8192), 16, 0, 0); } while (0)
#define PG8_LDA(dst, b, h) do { _Pragma("unroll") for (int m = 0; m < 4; ++m) _Pragma("unroll") for (int k = 0; k < 2; ++k) dst[m][k] = *(const LAS bf16x8*)(lds + PG8_SA(b, h) + aoff + m * 2048 + k * 1024); } while (0)
#define PG8_LDB(dst, b, h) do { _Pragma("unroll") for (int n = 0; n < 2; ++n) _Pragma("unroll") for (int k = 0; k < 2; ++k) dst[n][k] = *(const LAS bf16x8*)(lds + PG8_SB(b, h) + boff + n * 2048 + k * 1024); } while (0)
#define PG8_MMA(ai, bj, At, Bt) do { __builtin_amdgcn_s_setprio(1); _Pragma("unroll") for (int m = 0; m < 4; ++m) _Pragma("unroll") for (int n = 0; n < 2; ++n) _Pragma("unroll") for (int k = 0; k < 2; ++k) \
        acc[ai][bj][m][n] = __builtin_amdgcn_mfma_f32_16x16x32_bf16(Bt[n][k], At[m][k], acc[ai][bj][m][n], 0, 0, 0); __builtin_amdgcn_s_setprio(0); } while (0)
#define PG8_WAIT_V(n) asm volatile("s_waitcnt vmcnt(" #n ")" ::: "memory")
#define PG8_WAIT_L(n) asm volatile("s_waitcnt lgkmcnt(" #n ")" ::: "memory")
#define PG8_BAR __builtin_amdgcn_s_barrier()
#define PG8_SCHED __builtin_amdgcn_sched_barrier(0)
    Unit cur, nxt; int ui = 0;
    if (!S.next(0, cur)) return;
    f32x4 acc[2][2][4][2];
#pragma unroll
    for (int a = 0; a < 2; ++a)
#pragma unroll
        for (int b = 0; b < 2; ++b)
#pragma unroll
            for (int m = 0; m < 4; ++m)
#pragma unroll
                for (int n = 0; n < 2; ++n) acc[a][b][m][n] = (f32x4){0.f, 0.f, 0.f, 0.f};
    bf16x8 At[4][2], B0[2][2], B1[2][2];
    const char* cA = (const char*)g.A + (size_t)cur.pm * tstep; const char* cB = (const char*)g.Bt + (size_t)cur.pn * tstep;
    S.a_ready(cur);
    PG8_STAGE(PG8_SB(0, 0), cB, voffB); PG8_STAGE(PG8_SA(0, 0), cA, voffA); PG8_STAGE(PG8_SB(0, 1), cB + hstep, voffB); PG8_STAGE(PG8_SA(0, 1), cA + hstep, voffA);
    PG8_STAGE(PG8_SB(1, 0), cB + kstep, voffB); PG8_STAGE(PG8_SA(1, 0), cA + kstep, voffA); PG8_STAGE(PG8_SB(1, 1), cB + hstep + kstep, voffB);
    if (wr == 1) PG8_BAR;
    PG8_WAIT_V(10); PG8_BAR;
    PG8_WAIT_V(6); PG8_BAR;
#define PG8_KLOOP(KA_, KB_, KNA_, KNB_) \
        for (int t = 0; t < nt; t += 2) { \
            const bool last = (t == nt - 2); \
            const char* a1 = KA_ + (size_t)(t + 1) * kstep; \
            const char* a2 = last ? KNA_ : KA_ + (size_t)(t + 2) * kstep; const char* b2 = last ? KNB_ : KB_ + (size_t)(t + 2) * kstep; \
            const char* a3 = a2 + kstep; const char* b3 = b2 + kstep; \
            PG8_LDB(B0, 0, 0); PG8_SCHED; PG8_LDA(At, 0, 0); PG8_STAGE(PG8_SA(1, 1), a1 + hstep, voffA); \
            PG8_WAIT_L(8); PG8_BAR; PG8_WAIT_L(0); PG8_MMA(0, 0, At, B0); PG8_BAR; PG8_SCHED; \
            PG8_LDB(B1, 0, 1); PG8_STAGE(PG8_SB(0, 0), b2, voffB); \
            PG8_BAR; PG8_WAIT_L(0); PG8_MMA(0, 1, At, B1); PG8_BAR; \
            PG8_LDA(At, 0, 1); PG8_STAGE(PG8_SA(0, 0), a2, voffA); \
            PG8_BAR; PG8_WAIT_L(0); PG8_MMA(1, 0, At, B0); PG8_BAR; PG8_SCHED; \
            PG8_STAGE(PG8_SB(0, 1), b2 + hstep, voffB); \
            PG8_WAIT_V(6); PG8_BAR; PG8_MMA(1, 1, At, B1); PG8_BAR; \
            PG8_LDB(B0, 1, 0); PG8_SCHED; PG8_LDA(At, 1, 0); PG8_STAGE(PG8_SA(0, 1), a2 + hstep, voffA); \
            PG8_WAIT_L(8); PG8_BAR; PG8_WAIT_L(0); PG8_MMA(0, 0, At, B0); PG8_BAR; PG8_SCHED; \
            PG8_LDB(B1, 1, 1); PG8_STAGE(PG8_SB(1, 0), b3, voffB); \
            PG8_BAR; PG8_WAIT_L(0); PG8_MMA(0, 1, At, B1); PG8_BAR; \
            PG8_LDA(At, 1, 1); PG8_STAGE(PG8_SA(1, 0), a3, voffA); \
            PG8_BAR; PG8_WAIT_L(0); PG8_MMA(1, 0, At, B0); PG8_BAR; PG8_SCHED; \
            PG8_STAGE(PG8_SB(1, 1), b3 + hstep, voffB); \
            PG8_WAIT_V(6); PG8_BAR; PG8_MMA(1, 1, At, B1); PG8_BAR; \
        }
    for (;;) {
        const bool has_next = S.next(ui + 1, nxt);
        if constexpr (NSEG == 2) {
            const char* cA2 = (const char*)g.A2 + (size_t)cur.pm * tstep; const char* cB2 = (const char*)g.Bt2 + (size_t)cur.pn * tstep;
            PG8_KLOOP(cA, cB, cA2, cB2)
            { const int t2 = opaque_tid(), w2 = __builtin_amdgcn_readfirstlane(t2 >> 6), l2 = t2 & 63; E.mid(acc, cur, w2 >> 2, w2 & 3, l2 & 15, l2 >> 4); }
            const char* nA = has_next ? (const char*)g.A + (size_t)nxt.pm * tstep : cA2; const char* nB = has_next ? (const char*)g.Bt + (size_t)nxt.pn * tstep : cB2;
            PG8_KLOOP(cA2, cB2, nA, nB)
            cA = nA; cB = nB;
        } else {
            const char* nA = has_next ? (const char*)g.A + (size_t)nxt.pm * tstep : cA; const char* nB = has_next ? (const char*)g.Bt + (size_t)nxt.pn * tstep : cB;
            PG8_KLOOP(cA, cB, nA, nB)
            cA = nA; cB = nB;
        }
        if constexpr (!Epi::AFTER_DRAIN) { const int t2 = opaque_tid(), w2 = __builtin_amdgcn_readfirstlane(t2 >> 6), l2 = t2 & 63; E(acc, cur, w2 >> 2, w2 & 3, l2 & 15, l2 >> 4); }
        S.done(cur);
        if (!has_next) break;
#pragma unroll
        for (int a = 0; a < 2; ++a)
#pragma unroll
            for (int b = 0; b < 2; ++b)
#pragma unroll
                for (int m = 0; m < 4; ++m)
#pragma unroll
                    for (int n = 0; n < 2; ++n) acc[a][b][m][n] = (f32x4){0.f, 0.f, 0.f, 0.f};
        cur = nxt; ++ui;
    }
    PG8_WAIT_V(0);
    if (wr == 0) PG8_BAR;
    PG8_BAR;
    if constexpr (Epi::AFTER_DRAIN) E.fused(acc, cur, lds);
#undef PG8_KLOOP
#undef PG8_SA
#undef PG8_SB
#undef PG8_STAGE
#undef PG8_LDA
#undef PG8_LDB
#undef PG8_MMA
#undef PG8_WAIT_V
#undef PG8_WAIT_L
#undef PG8_BAR
#undef PG8_SCHED
}
#else
template <class Epi, class Sched, int NSEG = 1>
__device__ __forceinline__ void gemm_phase(LAS unsigned char* lds, const Gemm g, const Sched& S, const Epi& E) {
    const int tid = threadIdx.x, wid = tid >> 6, lane = tid & 63, wr = wid >> 2, wc = wid & 3, fr = lane & 15, fq = lane >> 4;
    const int K = g.K;
    Unit cur;
    for (int ui = 0; S.next(ui, cur); ++ui) {
        f32x4 acc[2][2][4][2];
#pragma unroll
        for (int a = 0; a < 2; ++a)
#pragma unroll
            for (int b = 0; b < 2; ++b)
#pragma unroll
                for (int m = 0; m < 4; ++m)
#pragma unroll
                    for (int n = 0; n < 2; ++n) acc[a][b][m][n] = (f32x4){0.f, 0.f, 0.f, 0.f};
        const bf16_t* Ab = g.A + (size_t)(cur.pm * BM + wr * 64 + fr) * K;
        const bf16_t* Bb = g.Bt + (size_t)(cur.pn * BM + wc * 32 + 8 * fq) * K;
        for (int k0 = 0; k0 < K; k0 += 2) {
            float a0[2][4], a1[2][4];
#pragma unroll
            for (int ai = 0; ai < 2; ++ai)
#pragma unroll
                for (int m = 0; m < 4; ++m) { const unsigned w = *(const unsigned*)(Ab + (size_t)(ai * HALF + m * 16) * K + k0); a0[ai][m] = bf_lo(w); a1[ai][m] = bf_hi(w); }
#pragma unroll
            for (int bj = 0; bj < 2; ++bj)
#pragma unroll
                for (int n = 0; n < 2; ++n)
#pragma unroll
                    for (int j = 0; j < 4; ++j) { const unsigned w = *(const unsigned*)(Bb + (size_t)(bj * HALF + 4 * n + j) * K + k0); const float b0 = bf_lo(w), b1 = bf_hi(w);
#pragma unroll
                        for (int ai = 0; ai < 2; ++ai)
#pragma unroll
                            for (int m = 0; m < 4; ++m) acc[ai][bj][m][n][j] += a0[ai][m] * b0 + a1[ai][m] * b1; }
        }
        if constexpr (Epi::AFTER_DRAIN) { __syncthreads(); E.fused(acc, cur, lds); } else E(acc, cur, wr, wc, fr, fq);
    }
    __syncthreads();
}
#endif
}
using pg8::Unit;

#define EPI_ROWS_BEGIN \
    const int row0 = u.pm * 256 + wr * 64 + fr, col0 = u.pn * 256 + wc * 32 + 8 * fq; \
    _Pragma("unroll") for (int ai = 0; ai < 2; ++ai) _Pragma("unroll") for (int m = 0; m < 4; ++m) { const int row = row0 + ai * 128 + m * 16;
#define EPI_COLS_BEGIN \
    _Pragma("unroll") for (int bj = 0; bj < 2; ++bj) { const int col = col0 + bj * 128; const f32x4 v0 = acc[ai][bj][m][0], v1 = acc[ai][bj][m][1]; \
        float v[8] = {v0[0], v0[1], v0[2], v0[3], v1[0], v1[1], v1[2], v1[3]};
#define EPI_END } }

struct EpiIn {
    static constexpr bool PERM = true, AFTER_DRAIN = false;
    bf16_t* P;
    __device__ __forceinline__ void operator()(f32x4 (&acc)[2][2][4][2], const Unit& u, int wr, int wc, int fr, int fq) const {
        const int mode = (u.pn < 20) ? 0 : 2;
        const __amdgpu_buffer_rsrc_t rs = wt_rsrc(P, (size_t)MTOK * NIN * 2);
        EPI_ROWS_BEGIN
        EPI_COLS_BEGIN
            if (mode == 1) {
#pragma unroll
                for (int j = 0; j < 8; ++j) v[j] = gelu_tanh(v[j]);
            } else if (mode == 2) {
#pragma unroll
                for (int j = 0; j < 8; ++j) v[j] = fast_sigmoid(v[j]);
            }
            store16_wt(rs, ((size_t)row * NIN + col) * 2, pack8(v));
        EPI_END
    }
};
struct EpiMix {
    static constexpr bool PERM = true, AFTER_DRAIN = false;
    const bf16_t* P; bf16_t* MRG;
    __device__ __forceinline__ void mid(f32x4 (&acc)[2][2][4][2], const Unit& u, int wr, int wc, int fr, int fq) const {
        const int row0 = u.pm * 256 + wr * 64 + fr, col0 = u.pn * 256 + wc * 32 + 8 * fq;
#pragma unroll
        for (int ai = 0; ai < 2; ++ai)
#pragma unroll
            for (int m = 0; m < 4; ++m) { const int row = row0 + ai * 128 + m * 16;
#pragma unroll
                for (int bj = 0; bj < 2; ++bj) { const int col = col0 + bj * 128;
                    float gl[8], gs[8]; unpack8(*(const u32x4*)(P + (size_t)row * NIN + PC_GL + col), gl); unpack8(*(const u32x4*)(P + (size_t)row * NIN + PC_GS + col), gs);
#pragma unroll
                    for (int j = 0; j < 8; ++j) { const float rt = gl[j] * __builtin_amdgcn_rcpf(fmaxf(gs[j], 1e-30f)); if (j < 4) acc[ai][bj][m][0][j] *= rt; else acc[ai][bj][m][1][j - 4] *= rt; } }
                if (m == 3) asm volatile("" ::: "memory"); }
    }
    __device__ __forceinline__ void operator()(f32x4 (&acc)[2][2][4][2], const Unit& u, int wr, int wc, int fr, int fq) const {
        const int row0 = u.pm * 256 + wr * 64 + fr, col0 = u.pn * 256 + wc * 32 + 8 * fq;
        const __amdgpu_buffer_rsrc_t rs = wt_rsrc(MRG, (size_t)MTOK * D * 2);
#pragma unroll
        for (int ai = 0; ai < 2; ++ai) {
            u32x4 gr[4][2];
#pragma unroll
            for (int m = 0; m < 4; ++m)
#pragma unroll
                for (int bj = 0; bj < 2; ++bj) gr[m][bj] = *(const u32x4*)(P + (size_t)(row0 + ai * 128 + m * 16) * NIN + PC_GS + col0 + bj * 128);
#pragma unroll
            for (int m = 0; m < 4; ++m)
#pragma unroll
                for (int bj = 0; bj < 2; ++bj) asm volatile("" : "+v"(gr[m][bj]));
#pragma unroll
            for (int m = 0; m < 4; ++m) { const int row = row0 + ai * 128 + m * 16;
#pragma unroll
                for (int bj = 0; bj < 2; ++bj) { const int col = col0 + bj * 128; const f32x4 v0 = acc[ai][bj][m][0], v1 = acc[ai][bj][m][1];
                    float v[8] = {v0[0], v0[1], v0[2], v0[3], v1[0], v1[1], v1[2], v1[3]};
                    float gs[8]; unpack8(gr[m][bj], gs);
#pragma unroll
                    for (int j = 0; j < 8; ++j) v[j] *= fmaxf(gs[j], 1e-30f);
                    store16_wt(rs, ((size_t)row * D + col) * 2, pack8(v)); } }
            asm volatile("" ::: "memory");
        }
    }
};
struct EpiO {
    static constexpr bool PERM = true, AFTER_DRAIN = false;
    const float* X; bf16_t* X1B; float* SQ;
    __device__ __forceinline__ void operator()(f32x4 (&acc)[2][2][4][2], const Unit& u, int wr, int wc, int fr, int fq) const {
        const int row0 = u.pm * 256 + wr * 64 + fr, col0 = u.pn * 256 + wc * 32 + 8 * fq;
        const __amdgpu_buffer_rsrc_t rs = wt_rsrc(X1B, (size_t)MTOK * D * 2);
#pragma unroll
        for (int ai = 0; ai < 2; ++ai)
#pragma unroll
            for (int mp = 0; mp < 2; ++mp) {
                f32x4 xr[2][2][2];
#pragma unroll
                for (int mm = 0; mm < 2; ++mm)
#pragma unroll
                    for (int bj = 0; bj < 2; ++bj) { const float* xp = X + (size_t)(row0 + ai * 128 + (2 * mp + mm) * 16) * D + col0 + bj * 128; xr[mm][bj][0] = *(const f32x4*)xp; xr[mm][bj][1] = *(const f32x4*)(xp + 4); }
#pragma unroll
                for (int mm = 0; mm < 2; ++mm)
#pragma unroll
                    for (int bj = 0; bj < 2; ++bj) asm volatile("" : "+v"(xr[mm][bj][0]), "+v"(xr[mm][bj][1]));
#pragma unroll
                for (int mm = 0; mm < 2; ++mm) { const int m = 2 * mp + mm, row = row0 + ai * 128 + m * 16; float ss = 0.f;
#pragma unroll
                    for (int bj = 0; bj < 2; ++bj) { const int col = col0 + bj * 128;
                        const f32x4 a = acc[ai][bj][m][0] + xr[mm][bj][0], b = acc[ai][bj][m][1] + xr[mm][bj][1];
                        float v[8] = {a[0], a[1], a[2], a[3], b[0], b[1], b[2], b[3]};
#pragma unroll
                        for (int j = 0; j < 8; ++j) ss += v[j] * v[j];
                        store16_wt(rs, ((size_t)x1b_phys_row(row) * D + col) * 2, pack8(v)); }
                    ss += __shfl_xor(ss, 16); ss += __shfl_xor(ss, 32);
                    if (fq == 0) SQ[(size_t)row * 32 + u.pn * 4 + wc] = ss; }
                asm volatile("" ::: "memory");
            }
    }
};
__device__ __forceinline__ float dpp_shr1(float old, float src) { return __int_as_float(__builtin_amdgcn_update_dpp(__float_as_int(old), __float_as_int(src), 0x111, 0xf, 0xf, false)); }
__device__ __forceinline__ float dpp_shr2(float old, float src) { return __int_as_float(__builtin_amdgcn_update_dpp(__float_as_int(old), __float_as_int(src), 0x112, 0xf, 0xf, false)); }
__device__ __forceinline__ float dpp_shr1z(float src) { return __int_as_float(__builtin_amdgcn_update_dpp(0, __float_as_int(src), 0x111, 0xf, 0xf, true)); }
__device__ __forceinline__ float dpp_shr2z(float src) { return __int_as_float(__builtin_amdgcn_update_dpp(0, __float_as_int(src), 0x112, 0xf, 0xf, true)); }
__device__ __forceinline__ float dpp_ror1(float src) { return __int_as_float(__builtin_amdgcn_update_dpp(0, __float_as_int(src), 0x121, 0xf, 0xf, false)); }
__device__ __forceinline__ float dpp_ror2(float src) { return __int_as_float(__builtin_amdgcn_update_dpp(0, __float_as_int(src), 0x122, 0xf, 0xf, false)); }
struct EpiUpConv {
    static constexpr bool PERM = true, AFTER_DRAIN = false;
    const float* SQ; bf16_t* FF; const float* cw; float* HALO; LAS float* hal; int* last_pm; int* ui;
    __device__ __forceinline__ void operator()(f32x4 (&acc)[2][2][4][2], const Unit& u, int wr, int wc, int fr, int fq) const {
        const int tid = opaque_tid();
        LAS float* rsl = hal + 2048; LAS float* wl = rsl + 256 + 768 * (*ui);
        const int row0 = u.pm * 256 + wr * 64 + fr;
        const int ch0 = u.pn * 128 + wc * 32 + 8 * fq;
        if (tid < 256 && u.pm != *last_pm) {
            const f32x4* sp = (const f32x4*)(SQ + (size_t)(u.pm * 256 + tid) * 32);
            f32x4 t = sp[0];
#pragma unroll
            for (int i = 1; i < 8; ++i) t += sp[i];
            rsl[tid] = 1.0f / sqrtf(((t[0] + t[1]) + (t[2] + t[3])) * (1.0f / D) + EPS);
        }
        if (fr == 15) {
#pragma unroll
            for (int ai = 0; ai < 2; ++ai) { LAS float* h = hal + ((((2 * ai + wr) * 4 + wc) * 4 + fq) * 2) * 16;
#pragma unroll
                for (int bj = 0; bj < 2; ++bj)
#pragma unroll
                    for (int n = 0; n < 2; ++n) { *(LAS f32x4*)(h + bj * 8 + n * 4) = acc[ai][bj][2][n]; *(LAS f32x4*)(h + 16 + bj * 8 + n * 4) = acc[ai][bj][3][n]; } }
        }
        asm volatile("s_waitcnt lgkmcnt(0)" ::: "memory"); __builtin_amdgcn_s_barrier(); __builtin_amdgcn_s_barrier(); asm volatile("" ::: "memory");
        float r[2][4], rp62[2], rp63[2];
#pragma unroll
        for (int ai = 0; ai < 2; ++ai) {
            const int strip = 2 * ai + wr;
            const f32x4 rr = *(const LAS f32x4*)(rsl + 64 * strip + 4 * fr);
            r[ai][0] = rr[0]; r[ai][1] = rr[1]; r[ai][2] = rr[2]; r[ai][3] = rr[3];
            rp62[ai] = 0.f; rp63[ai] = 0.f;
            if (strip > 0) { rp62[ai] = rsl[64 * strip - 2]; rp63[ai] = rsl[64 * strip - 1]; }
        }
        if (wr == 0 && fr == 0) {
#pragma unroll
            for (int m = 0; m < 2; ++m) { float* g = HALO + (size_t)(u.pm * 4 + m) * NUP + u.pn * 256 + wc * 32 + 8 * fq;
#pragma unroll
                for (int bj = 0; bj < 2; ++bj) { *(f32x4*)(g + bj * 128) = acc[0][bj][m][0] * r[0][m]; *(f32x4*)(g + bj * 128 + 4) = acc[0][bj][m][1] * r[0][m]; } } }
        if (wr == 1 && fr == 15) {
#pragma unroll
            for (int m = 2; m < 4; ++m) { float* g = HALO + (size_t)(u.pm * 4 + m) * NUP + u.pn * 256 + wc * 32 + 8 * fq;
#pragma unroll
                for (int bj = 0; bj < 2; ++bj) { *(f32x4*)(g + bj * 128) = acc[1][bj][m][0] * r[1][m]; *(f32x4*)(g + bj * 128 + 4) = acc[1][bj][m][1] * r[1][m]; } } }
        asm volatile("" ::: "memory");
        const __amdgpu_buffer_rsrc_t ffrs = wt_rsrc(FF, (size_t)MTOK * DFF * 2);
#pragma unroll
        for (int ai = 0; ai < 2; ++ai) {
            const int strip = 2 * ai + wr;
#pragma unroll
            for (int bj = 0; bj < 2; ++bj)
#pragma unroll
                for (int n = 0; n < 2; ++n) {
                    const int tcol = bj * 128 + wc * 32 + 8 * fq + 4 * n;
                    const f32x4 w0 = *(const LAS f32x4*)(wl + tcol), w1 = *(const LAS f32x4*)(wl + 256 + tcol), w2 = *(const LAS f32x4*)(wl + 512 + tcol);
                    f32x4 q62 = {0.f, 0.f, 0.f, 0.f}, q63 = {0.f, 0.f, 0.f, 0.f};
                    if (strip > 0) { const LAS float* h = hal + ((((strip - 1) * 4 + wc) * 4 + fq) * 2) * 16 + bj * 8 + n * 4;
                        q62 = *(const LAS f32x4*)h * rp62[ai]; q63 = *(const LAS f32x4*)(h + 16) * rp63[ai]; }
                    LDS_WAIT(); __builtin_amdgcn_sched_barrier(0);
#pragma unroll
                    for (int j = 0; j < 4; ++j) {
                        const float c0 = acc[ai][bj][0][n][j] * r[ai][0], c1 = acc[ai][bj][1][n][j] * r[ai][1], c2 = acc[ai][bj][2][n][j] * r[ai][2], c3 = acc[ai][bj][3][n][j] * r[ai][3];
                        const float x3 = dpp_shr1(q63[j], c3), x2 = dpp_shr1(q62[j], c2);
                        float v0 = fmaf(w0[j], x2, fmaf(w1[j], x3, w2[j] * c0));
                        float v1 = fmaf(w0[j], x3, fmaf(w1[j], c0, w2[j] * c1));
                        float v2 = fmaf(w0[j], c0, fmaf(w1[j], c1, w2[j] * c2));
                        float v3 = fmaf(w0[j], c1, fmaf(w1[j], c2, w2[j] * c3));
                        asm volatile("" : "+v"(v0), "+v"(v1), "+v"(v2), "+v"(v3));
                        acc[ai][bj][0][n][j] = v0; acc[ai][bj][1][n][j] = v1; acc[ai][bj][2][n][j] = v2; acc[ai][bj][3][n][j] = v3;
                    }
                    asm volatile("" ::: "memory"); __builtin_amdgcn_sched_barrier(0);
                }
#pragma unroll
            for (int m = 0; m < 4; ++m) { const int row = u.pm * 256 + 64 * strip + 4 * fr + m;
                float o[8];
#pragma unroll
                for (int n = 0; n < 2; ++n)
#pragma unroll
                    for (int j = 0; j < 4; ++j) { const float g = acc[ai][0][m][n][j]; o[4 * n + j] = g * fast_sigmoid(g) * acc[ai][1][m][n][j]; }
                store16_wt(ffrs, ((size_t)row * DFF + ch0) * 2, pack8(o)); }
            asm volatile("" ::: "memory"); __builtin_amdgcn_sched_barrier(0);
        }
        *last_pm = u.pm; *ui += 1;
    }
};
__device__ __forceinline__ void ff_fixup(const float* HALO, const float* cw, bf16_t* FF, int pm) {
    if ((pm & 15) == 0) return;
    constexpr int NIT = DFF / 4;
    const int t0 = opaque_tid();
    f32x4 hg[3][4], hv[3][4], wg[3][3], wv[3][3];
#pragma unroll
    for (int q = 0; q < 3; ++q) {
        const int it = t0 + 512 * q, itc = it < NIT ? it : NIT - 1, c4 = itc * 4, pn = c4 >> 7, jj = c4 & 127, tc = pn * 256 + jj;
        const float* T0 = HALO + (size_t)((pm - 1) * 4 + 2) * NUP + tc;
        const float* H0 = HALO + (size_t)(pm * 4) * NUP + tc;
        hg[q][0] = *(const f32x4*)T0; hg[q][1] = *(const f32x4*)(T0 + NUP); hg[q][2] = *(const f32x4*)H0; hg[q][3] = *(const f32x4*)(H0 + NUP);
        hv[q][0] = *(const f32x4*)(T0 + 128); hv[q][1] = *(const f32x4*)(T0 + NUP + 128); hv[q][2] = *(const f32x4*)(H0 + 128); hv[q][3] = *(const f32x4*)(H0 + NUP + 128);
#pragma unroll
        for (int k = 0; k < 3; ++k) { wg[q][k] = *(const f32x4*)(cw + k * NUP + c4); wv[q][k] = *(const f32x4*)(cw + k * NUP + DFF + c4); }
    }
#pragma unroll
    for (int q = 0; q < 3; ++q) {
#pragma unroll
        for (int k = 0; k < 4; ++k) asm volatile("" : "+v"(hg[q][k]), "+v"(hv[q][k]));
#pragma unroll
        for (int k = 0; k < 3; ++k) asm volatile("" : "+v"(wg[q][k]), "+v"(wv[q][k]));
    }
#pragma unroll
    for (int q = 0; q < 3; ++q) {
        const int it = t0 + 512 * q;
        if (it < NIT) {
#pragma unroll
            for (int rsel = 0; rsel < 2; ++rsel) {
                float o[4];
#pragma unroll
                for (int j = 0; j < 4; ++j) { const float g = wg[q][0][j] * hg[q][rsel][j] + wg[q][1][j] * hg[q][rsel + 1][j] + wg[q][2][j] * hg[q][rsel + 2][j];
                    const float v = wv[q][0][j] * hv[q][rsel][j] + wv[q][1][j] * hv[q][rsel + 1][j] + wv[q][2][j] * hv[q][rsel + 2][j]; o[j] = g * fast_sigmoid(g) * v; }
                u32x2 w; w.x = cvt_pk_bf16(o[0], o[1]); w.y = cvt_pk_bf16(o[2], o[3]);
                *(u32x2*)(FF + (size_t)(pm * 256 + rsel) * DFF + it * 4) = w;
            }
        }
    }
}
struct EpiDnNorm {
    static constexpr bool PERM = true, AFTER_DRAIN = true;
    float* X; const bf16_t* X1B; const float* gfin; float* SQ2; unsigned* cnt;
    __device__ __forceinline__ void fused(f32x4 (&acc)[2][2][4][2], const Unit& u, LAS unsigned char* lds) const {
        const int tid = opaque_tid(), wid = __builtin_amdgcn_readfirstlane(tid >> 6), lane = tid & 63, wr = wid >> 2, wc = wid & 3, fr = lane & 15, fq = lane >> 4;
        LAS float* part = (LAS float*)lds;
        LAS float* rs = part + 1024;
        const int row0 = u.pm * 256 + wr * 64 + fr, col0 = u.pn * 256 + wc * 32 + 8 * fq;
#pragma unroll
        for (int ai = 0; ai < 2; ++ai) {
            u32x4 xr[4][2];
#pragma unroll
            for (int m = 0; m < 4; ++m)
#pragma unroll
                for (int bj = 0; bj < 2; ++bj) xr[m][bj] = *(const u32x4*)(X1B + (size_t)x1b_phys_row(row0 + ai * 128 + m * 16) * D + col0 + bj * 128);
#pragma unroll
            for (int m = 0; m < 4; ++m)
#pragma unroll
                for (int bj = 0; bj < 2; ++bj) asm volatile("" : "+v"(xr[m][bj]));
#pragma unroll
            for (int m = 0; m < 4; ++m) { float ss = 0.f;
#pragma unroll
                for (int bj = 0; bj < 2; ++bj) { float xv[8]; unpack8(xr[m][bj], xv);
                    acc[ai][bj][m][0] += (f32x4){xv[0], xv[1], xv[2], xv[3]}; acc[ai][bj][m][1] += (f32x4){xv[4], xv[5], xv[6], xv[7]};
                    const f32x4 a = acc[ai][bj][m][0], b = acc[ai][bj][m][1];
                    ss += (a[0] * a[0] + a[1] * a[1]) + (a[2] * a[2] + a[3] * a[3]) + (b[0] * b[0] + b[1] * b[1]) + (b[2] * b[2] + b[3] * b[3]); }
                ss += __shfl_xor(ss, 16); ss += __shfl_xor(ss, 32);
                if (fq == 0) part[(ai * 128 + wr * 64 + m * 16 + fr) * 4 + wc] = ss; }
        }
        __syncthreads();
        if (tid < 256) { const f32x4 q = *(const LAS f32x4*)(part + tid * 4);
            __hip_atomic_store(SQ2 + ((size_t)u.pm * 8 + u.pn) * 256 + tid, (q[0] + q[1]) + (q[2] + q[3]), __ATOMIC_RELAXED, __HIP_MEMORY_SCOPE_AGENT); }
        asm volatile("s_waitcnt vmcnt(0)" ::: "memory");
        __syncthreads();
        if (tid == 0) {
            __hip_atomic_fetch_add(cnt + 64 * u.pm, 1u, __ATOMIC_RELAXED, __HIP_MEMORY_SCOPE_AGENT);
            for (int spin = 0; spin < (1 << 24); ++spin) { if (__hip_atomic_load(cnt + 64 * u.pm, __ATOMIC_RELAXED, __HIP_MEMORY_SCOPE_AGENT) >= 8u) break; __builtin_amdgcn_s_sleep(2); }
        }
        __syncthreads();
        if (tid < 256) { float tot = 0.f;
#pragma unroll
            for (int q = 0; q < 8; ++q) tot += __hip_atomic_load(SQ2 + ((size_t)u.pm * 8 + q) * 256 + tid, __ATOMIC_RELAXED, __HIP_MEMORY_SCOPE_AGENT);
            rs[tid] = 1.0f / sqrtf(tot * (1.0f / D) + EPS); }
        __syncthreads();
        f32x4 g[2][2];
#pragma unroll
        for (int bj = 0; bj < 2; ++bj) { g[bj][0] = *(const f32x4*)(gfin + col0 + bj * 128); g[bj][1] = *(const f32x4*)(gfin + col0 + bj * 128 + 4); }
#pragma unroll
        for (int ai = 0; ai < 2; ++ai)
#pragma unroll
            for (int m = 0; m < 4; ++m) { const int rl = ai * 128 + wr * 64 + m * 16 + fr; const float r = rs[rl]; float* o = X + (size_t)(u.pm * 256 + rl) * D + col0;
#pragma unroll
                for (int bj = 0; bj < 2; ++bj) { *(f32x4*)(o + bj * 128) = acc[ai][bj][m][0] * r * g[bj][0]; *(f32x4*)(o + bj * 128 + 4) = acc[ai][bj][m][1] * r * g[bj][1]; } }
    }
};

template <bool NTOUT>
__device__ __forceinline__ void p0_item64(const float* __restrict__ W, int K, int N, bf16_t* __restrict__ WT, const float* __restrict__ gk, LAS float* scr, int kb, int nb, int out_row0, int lane) {
    const int k0 = 64 * kb, n0 = 64 * nb, kq = lane >> 4, nq = 4 * (lane & 15);
    f32x4 v[16];
#pragma unroll
    for (int i = 0; i < 16; ++i) v[i] = __builtin_nontemporal_load((const f32x4*)(W + (size_t)(k0 + 4 * i + kq) * N + n0 + nq));
    if (gk) {
#pragma unroll
        for (int i = 0; i < 16; ++i) v[i] *= gk[k0 + 4 * i + kq];
    }
#pragma unroll
    for (int i = 0; i < 16; ++i) { LAS float* d = scr + (4 * i + kq) * 65 + nq; d[0] = v[i][0]; d[1] = v[i][1]; d[2] = v[i][2]; d[3] = v[i][3]; }
    LDS_WAIT();
    const int c = lane & 7;
#pragma unroll
    for (int j = 0; j < 8; ++j) { const int n = (lane >> 3) + 8 * j; const LAS float* s = scr + (8 * c) * 65 + n;
        u32x4 o; o.x = cvt_pk_bf16(s[0 * 65], s[1 * 65]); o.y = cvt_pk_bf16(s[2 * 65], s[3 * 65]); o.z = cvt_pk_bf16(s[4 * 65], s[5 * 65]); o.w = cvt_pk_bf16(s[6 * 65], s[7 * 65]);
        if (NTOUT) __builtin_nontemporal_store(o, (u32x4*)(WT + (size_t)(out_row0 + n) * K + k0 + 8 * c)); else *(u32x4*)(WT + (size_t)(out_row0 + n) * K + k0 + 8 * c) = o; }
    LDS_WAIT();
}
template <bool UPPERM, bool NTOUT = false>
__device__ __forceinline__ void convert_matrix(const float* W, int K, int N, bf16_t* WT, const float* gk, LAS unsigned char* lds, int wk, int nworkers) {
    const int tid = opaque_tid(), lane = tid & 63, wave = tid >> 6;
    LAS float* scr = (LAS float*)(lds + wave * 16640);
    const int nblk = N / 64, items = (K / 64) * nblk;
    for (int it = wk * 8 + wave; it < items; it += nworkers * 8) {
        const int kb = it / nblk, nb = it % nblk;
        int orow = 64 * nb;
        if (UPPERM) { const int bj = nb / (DFF / 64), rem = nb % (DFF / 64); orow = 256 * (rem >> 1) + 128 * bj + 64 * (rem & 1); }
        p0_item64<NTOUT>(W, K, N, WT, gk, scr, kb, nb, orow, lane);
    }
}

__device__ __forceinline__ void phase0(const Params& p, LAS unsigned char* lds) {
    const int tid = opaque_tid(), lane = tid & 63, wave = tid >> 6;
    const int gw = blockIdx.x * 8 + wave, NGW = gridDim.x * 8;
    unsigned char* ws = p.ws;
    const float* x = p.in[0]; const float* g = p.in[1]; bf16_t* H = (bf16_t*)(ws + OFF_HREG);
    for (int m = gw * 2; m < MTOK; m += NGW * 2) {
        const f32x4* xr = (const f32x4*)(x + (size_t)m * D) + lane; const f32x4* gr = (const f32x4*)g + lane;
        f32x4 v[2][8]; float s0 = 0.f, s1 = 0.f;
#pragma unroll
        for (int j = 0; j < 8; ++j) { v[0][j] = __builtin_nontemporal_load(xr + 64 * j); v[1][j] = __builtin_nontemporal_load(xr + 512 + 64 * j); }
#pragma unroll
        for (int j = 0; j < 8; ++j) { s0 += (v[0][j][0] * v[0][j][0] + v[0][j][1] * v[0][j][1]) + (v[0][j][2] * v[0][j][2] + v[0][j][3] * v[0][j][3]);
                                      s1 += (v[1][j][0] * v[1][j][0] + v[1][j][1] * v[1][j][1]) + (v[1][j][2] * v[1][j][2] + v[1][j][3] * v[1][j][3]); }
        const float rs0 = 1.0f / sqrtf(wave_sum(s0) * (1.0f / D) + EPS), rs1 = 1.0f / sqrtf(wave_sum(s1) * (1.0f / D) + EPS);
        u32x2* o = (u32x2*)(H + (size_t)m * D) + lane;
#pragma unroll
        for (int j = 0; j < 8; ++j) { const f32x4 gg = gr[64 * j]; u32x2 w;
            w.x = cvt_pk_bf16(v[0][j][0] * rs0 * gg[0], v[0][j][1] * rs0 * gg[1]); w.y = cvt_pk_bf16(v[0][j][2] * rs0 * gg[2], v[0][j][3] * rs0 * gg[3]); o[64 * j] = w;
            w.x = cvt_pk_bf16(v[1][j][0] * rs1 * gg[0], v[1][j][1] * rs1 * gg[1]); w.y = cvt_pk_bf16(v[1][j][2] * rs1 * gg[2], v[1][j][3] * rs1 * gg[3]); o[512 + 64 * j] = w; }
    }
    if (blockIdx.x == 0 && tid < 64) ((unsigned*)(ws + OFF_CNT))[64 * tid] = 0u;
    const int G = gridDim.x, c = blockIdx.x;
    convert_matrix<false>(p.in[2], D, NIN, (bf16_t*)(ws + OFF_WINT), nullptr, lds, c, G);
}

constexpr int BP = 72;
constexpr int FP = 68;
constexpr int LRU_WAVE_LDS = 16 * BP * 2 + 2 * 16 * FP * 4;
constexpr int LRU_UNITS = NB * NH * 8;
__device__ __forceinline__ void lru_partA(const Params& p, LAS unsigned char* lds, int unit, float (&hloc)[64], float (&cumA)[64], float& Aex, float& hex, unsigned (&gpk)[32]) {
    const int tid = opaque_tid(), lane = tid & 63, wave = __builtin_amdgcn_readfirstlane(tid >> 6);
    const int bc = unit & 7, hd = (unit >> 3) & (NH - 1), b = unit >> 7;
    const int ch0 = hd * HD, tw0 = bc * 512 + wave * 64;
    LAS bf16_t* wab = (LAS bf16_t*)lds; LAS bf16_t* wxb = wab + 64 * BP;
    LAS float* totA = (LAS float*)(lds + 18432); LAS float* totH = totA + 512;
    LAS unsigned char* wl = lds + 22528 + wave * LRU_WAVE_LDS;
    LAS bf16_t* xcb = (LAS bf16_t*)wl; LAS float* us = (LAS float*)(wl + 16 * BP * 2); LAS float* as_ = us + 16 * FP;
    const bf16_t* P = (const bf16_t*)(p.ws + OFF_P);
    const float* cw = p.in[3]; const float* cb = p.in[4]; const float* wa = p.in[5]; const float* ba = p.in[6]; const float* wx = p.in[7]; const float* bx = p.in[8]; const float* lam = p.in[9];
    {
        const int e = tid * 8, i = e >> 6, j0 = e & 63;
        const float* s1 = wa + (size_t)hd * 4096 + e; const float* s2 = wx + (size_t)hd * 4096 + e;
        const f32x4 a0 = *(const f32x4*)s1, a1 = *(const f32x4*)(s1 + 4), x0 = *(const f32x4*)s2, x1 = *(const f32x4*)(s2 + 4);
        const float av[8] = {a0[0], a0[1], a0[2], a0[3], a1[0], a1[1], a1[2], a1[3]}; const float xv[8] = {x0[0], x0[1], x0[2], x0[3], x1[0], x1[1], x1[2], x1[3]};
#pragma unroll
        for (int q = 0; q < 8; ++q) { wab[(j0 + q) * BP + i] = (bf16_t)(cvt_pk_bf16(av[q], 0.f) & 0xffffu); wxb[(j0 + q) * BP + i] = (bf16_t)(cvt_pk_bf16(xv[q], 0.f) & 0xffffu); }
    }
    const int ctl = lane >> 3, c8 = (lane & 7) * 8;
    float w4[4][8], bb[8];
#pragma unroll
    for (int k = 0; k < 4; ++k) { const f32x4 q0 = *(const f32x4*)(cw + k * DL + ch0 + c8), q1 = *(const f32x4*)(cw + k * DL + ch0 + c8 + 4);
        w4[k][0] = q0[0]; w4[k][1] = q0[1]; w4[k][2] = q0[2]; w4[k][3] = q0[3]; w4[k][4] = q1[0]; w4[k][5] = q1[1]; w4[k][6] = q1[2]; w4[k][7] = q1[3]; }
    { const f32x4 q0 = *(const f32x4*)(cb + ch0 + c8), q1 = *(const f32x4*)(cb + ch0 + c8 + 4); bb[0] = q0[0]; bb[1] = q0[1]; bb[2] = q0[2]; bb[3] = q0[3]; bb[4] = q1[0]; bb[5] = q1[1]; bb[6] = q1[2]; bb[7] = q1[3]; }
    const int r16 = lane & 15, quad = lane >> 4;
    float bav[4], bxv[4], sp8[4];
#pragma unroll
    for (int ct = 0; ct < 4; ++ct) { const int ch = ch0 + 16 * ct + r16; bav[ct] = ba[ch]; bxv[ct] = bx[ch]; sp8[ct] = -8.0f * log1pf(__expf(-lam[ch])); }
    __syncthreads();
    float h = 0.f, A = 1.f;
#pragma unroll
    for (int sc = 0; sc < 4; ++sc) {
        const int ts0 = tw0 + 16 * sc;
#pragma unroll
        for (int ps = 0; ps < 2; ++ps) {
            const int tl = ps * 8 + ctl;
            float xc[8];
#pragma unroll
            for (int j = 0; j < 8; ++j) xc[j] = bb[j];
#pragma unroll
            for (int k = 0; k < 4; ++k) {
                const int tt = ts0 + tl - 3 + k;
                if (tt >= 0) { float xin[8]; unpack8(*(const u32x4*)(P + (size_t)(b * SEQ + tt) * NIN + PC_LX + ch0 + c8), xin);
#pragma unroll
                    for (int j = 0; j < 8; ++j) xc[j] += w4[k][j] * xin[j]; }
            }
            *(LAS f32x4*)(us + tl * FP + c8) = (f32x4){xc[0], xc[1], xc[2], xc[3]}; *(LAS f32x4*)(us + tl * FP + c8 + 4) = (f32x4){xc[4], xc[5], xc[6], xc[7]};
            *(LAS u32x4*)(xcb + tl * BP + c8) = pack8(xc);
        }
        LDS_WAIT();
        {
            bf16x8 af[2];
#pragma unroll
            for (int kk = 0; kk < 2; ++kk) af[kk] = *(const LAS bf16x8*)(xcb + r16 * BP + kk * 32 + quad * 8);
#pragma unroll
            for (int ct = 0; ct < 4; ++ct) {
                f32x4 ar = {0.f, 0.f, 0.f, 0.f}, ai = {0.f, 0.f, 0.f, 0.f};
#pragma unroll
                for (int kk = 0; kk < 2; ++kk) {
                    const bf16x8 b1 = *(const LAS bf16x8*)(wab + (16 * ct + r16) * BP + kk * 32 + quad * 8);
                    const bf16x8 b2 = *(const LAS bf16x8*)(wxb + (16 * ct + r16) * BP + kk * 32 + quad * 8);
                    ar = __builtin_amdgcn_mfma_f32_16x16x32_bf16(af[kk], b1, ar, 0, 0, 0);
                    ai = __builtin_amdgcn_mfma_f32_16x16x32_bf16(af[kk], b2, ai, 0, 0, 0);
                }
                const int j = 16 * ct + r16;
#pragma unroll
                for (int rg = 0; rg < 4; ++rg) {
                    const int t = quad * 4 + rg;
                    const float r = fast_sigmoid(ar[rg] + bav[ct]), ig = fast_sigmoid(ai[rg] + bxv[ct]);
                    const float a = __builtin_amdgcn_exp2f(1.4426950408889634f * (sp8[ct] * r)), mult = sqrtf(fmaxf(fmaf(-a, a, 1.0f), 0.f));
                    const float xc = us[t * FP + j];
                    us[t * FP + j] = mult * (ig * xc); as_[t * FP + j] = a;
                }
            }
        }
        LDS_WAIT();
#pragma unroll
        for (int s = 0; s < 16; ++s) { const float a = as_[s * FP + lane], uu = us[s * FP + lane]; h = a * h + uu; A *= a; hloc[sc * 16 + s] = h; cumA[sc * 16 + s] = A; }
        LDS_WAIT();
    }
    totA[wave * 64 + lane] = A; totH[wave * 64 + lane] = h;
    {
        const bf16_t* G = P + (size_t)(b * SEQ + tw0) * NIN + PC_LG + ch0 + lane;
#pragma unroll
        for (int s2 = 0; s2 < 32; ++s2) gpk[s2] = (unsigned)G[(size_t)(2 * s2) * NIN] | ((unsigned)G[(size_t)(2 * s2 + 1) * NIN] << 16);
    }
    __syncthreads();
    Aex = 1.f; hex = 0.f;
    for (int w = 0; w < wave; ++w) { const float a = totA[w * 64 + lane], hh = totH[w * 64 + lane]; hex = a * hex + hh; Aex *= a; }
    if (wave == 7) {
        const size_t o = (size_t)(b * 8 + bc) * DL + ch0 + lane;
        __hip_atomic_store((float*)(p.ws + OFF_LA) + o, Aex * A, __ATOMIC_RELAXED, __HIP_MEMORY_SCOPE_AGENT);
        __hip_atomic_store((float*)(p.ws + OFF_LH) + o, A * hex + h, __ATOMIC_RELAXED, __HIP_MEMORY_SCOPE_AGENT);
        asm volatile("s_waitcnt vmcnt(0)" ::: "memory");
        if (lane == 0) __hip_atomic_fetch_add((unsigned*)(p.ws + OFF_CNT) + 64 * (32 + b * NH + hd), 1u, __ATOMIC_RELAXED, __HIP_MEMORY_SCOPE_AGENT);
    }
}
__device__ __forceinline__ void lru_partB(const Params& p, int unit, const float (&hloc)[64], const float (&cumA)[64], float Aex, float hex, const unsigned (&gpk)[32]) {
    const int tid = opaque_tid(), lane = tid & 63, wave = __builtin_amdgcn_readfirstlane(tid >> 6);
    const int bc = unit & 7, hd = (unit >> 3) & (NH - 1), b = unit >> 7;
    const int ch0 = hd * HD, tw0 = bc * 512 + wave * 64;
    const float* LA = (const float*)(p.ws + OFF_LA); const float* LH = (const float*)(p.ws + OFF_LH);
    if (bc > 0) {
        if (tid == 0) { unsigned* cn = (unsigned*)(p.ws + OFF_CNT) + 64 * (32 + b * NH + hd);
            for (int spin = 0; spin < (1 << 24); ++spin) { if (__hip_atomic_load(cn, __ATOMIC_RELAXED, __HIP_MEMORY_SCOPE_AGENT) >= 8u) break; __builtin_amdgcn_s_sleep(1); } }
        __syncthreads();
    }
    float hin = 0.f;
    for (int c2 = 0; c2 < bc; ++c2) { const size_t o = (size_t)(b * 8 + c2) * DL + ch0 + lane;
        hin = __hip_atomic_load((float*)LA + o, __ATOMIC_RELAXED, __HIP_MEMORY_SCOPE_AGENT) * hin + __hip_atomic_load((float*)LH + o, __ATOMIC_RELAXED, __HIP_MEMORY_SCOPE_AGENT); }
    const float hw = Aex * hin + hex;
    bf16_t* O = (bf16_t*)(p.ws + OFF_HREG) + (size_t)(b * SEQ + tw0) * DL + ch0 + lane;
#pragma unroll
    for (int s = 0; s < 64; ++s) { const float gt = gelu_tanh((s & 1) ? bf_hi(gpk[s >> 1]) : bf_lo(gpk[s >> 1]));
        O[(size_t)s * DL] = (bf16_t)(cvt_pk_bf16((hloc[s] + cumA[s] * hw) * gt, 0.f) & 0xffffu); }
}

__device__ __forceinline__ void sc_item_load(const bf16_t* P, int it, u32x4 (&cv)[3], u32x4 (&vv)[3], u32x4& bv) {
    const int row = it / (DS / 8), c8 = (it % (DS / 8)) * 8, t = row % SEQ;
#pragma unroll
    for (int k = 0; k < 3; ++k) {
        const int rr = (t - 2 + k >= 0) ? (row - 2 + k) : row;
        const bf16_t* pr = P + (size_t)rr * NIN + c8;
        cv[k] = *(const u32x4*)(pr + PC_SC); vv[k] = *(const u32x4*)(pr + PC_SV);
    }
    bv = *(const u32x4*)(P + (size_t)row * NIN + PC_SB + c8);
}
__device__ __forceinline__ void sc_item_finish(const float* cw, bf16_t* ASC, int it, const u32x4 (&cv)[3], const u32x4 (&vv)[3], const u32x4& bv) {
    const int row = it / (DS / 8), c8 = (it % (DS / 8)) * 8, t = row % SEQ;
    float acc[8] = {0.f, 0.f, 0.f, 0.f, 0.f, 0.f, 0.f, 0.f};
#pragma unroll
    for (int k = 0; k < 3; ++k) {
        float c[8], v[8]; unpack8(cv[k], c); unpack8(vv[k], v);
        const f32x4 w0 = *(const f32x4*)(cw + k * DS + c8), w1 = *(const f32x4*)(cw + k * DS + c8 + 4);
        const float wv[8] = {w0[0], w0[1], w0[2], w0[3], w1[0], w1[1], w1[2], w1[3]};
        const float msk = (t - 2 + k >= 0) ? 1.0f : 0.0f;
#pragma unroll
        for (int j = 0; j < 8; ++j) acc[j] += (msk * wv[j]) * (c[j] * v[j]);
    }
    float b[8]; unpack8(bv, b);
#pragma unroll
    for (int j = 0; j < 8; ++j) acc[j] *= b[j];
    *(u32x4*)(ASC + (size_t)row * DS + c8) = pack8(acc);
}
__device__ __forceinline__ void sc_phase(const Params& p) {
    const bf16_t* P = (const bf16_t*)(p.ws + OFF_P);
    bf16_t* ASC = (bf16_t*)(p.ws + OFF_HREG) + (size_t)MTOK * DL;
    const float* cw = p.in[11];
    const int nth = gridDim.x * 512, NIT = MTOK * (DS / 8);
    for (int it = blockIdx.x * 512 + opaque_tid(); it < NIT; it += 4 * nth) {
        u32x4 cv[4][3], vv[4][3], bv[4];
#pragma unroll
        for (int q = 0; q < 4; ++q) if (it + q * nth < NIT) sc_item_load(P, it + q * nth, cv[q], vv[q], bv[q]);
#pragma unroll
        for (int q = 0; q < 4; ++q) if (it + q * nth < NIT) sc_item_finish(cw, ASC, it + q * nth, cv[q], vv[q], bv[q]);
    }
}

__device__ __forceinline__ void final_norm_phase(const Params& p) {
    const int tid = opaque_tid(), lane = tid & 63, wave = tid >> 6;
    const int gw = blockIdx.x * 8 + wave, NGW = gridDim.x * 8;
    const float* g = p.in[18];
    for (int m = gw; m < MTOK; m += NGW) {
        f32x4* xr = (f32x4*)(p.out + (size_t)m * D) + lane; const f32x4* gr = (const f32x4*)g + lane;
        f32x4 v[8]; float s = 0.f;
#pragma unroll
        for (int j = 0; j < 8; ++j) { v[j] = xr[64 * j]; s += (v[j][0] * v[j][0] + v[j][1] * v[j][1]) + (v[j][2] * v[j][2] + v[j][3] * v[j][3]); }
        const float rstd = 1.0f / sqrtf(wave_sum(s) * (1.0f / D) + EPS);
#pragma unroll
        for (int j = 0; j < 8; ++j) { const f32x4 gg = gr[64 * j]; xr[64 * j] = (f32x4){v[j][0] * rstd * gg[0], v[j][1] * rstd * gg[1], v[j][2] * rstd * gg[2], v[j][3] * rstd * gg[3]}; }
    }
}

#define XB_TMO      128
#define XB_XCNT(j)  (256  + 64 * (j))
#define XB_XSUB(j)  (1280 + 64 * (j))
#define XB_XGEN(j)  (2304 + 64 * (j))
#define XB_TOP      3328
#define XB_TOPGEN   3392
#define XCD_BAR_WORDS 3456
#define XB_SPIN_CAP (1u << 18)

__device__ __forceinline__ unsigned xb_ld(unsigned* p)              { return __hip_atomic_load(p, __ATOMIC_RELAXED, __HIP_MEMORY_SCOPE_AGENT); }
__device__ __forceinline__ unsigned xb_add(unsigned* p, unsigned v) { return __hip_atomic_fetch_add(p, v, __ATOMIC_RELAXED, __HIP_MEMORY_SCOPE_AGENT); }
__device__ __forceinline__ unsigned xb_xcc_id() { return (unsigned)__builtin_amdgcn_s_getreg((3 << 11) | 20) & 0xFu; }
#define XB_SPIN(cond, bar) do { unsigned _sp = 0; while (cond) { __builtin_amdgcn_s_sleep(1); \
    if ((++_sp & 255u) == 0u) { if (xb_ld(&(bar)[XB_TMO])) break; if (_sp > XB_SPIN_CAP) { atomicAdd(&(bar)[XB_TMO], 1u); break; } } } } while (0)

struct XcdBarrier {
    unsigned* bar; unsigned x;
    volatile LAS unsigned* st;
};

__device__ __forceinline__ XcdBarrier xcd_barrier_post(unsigned* bar, volatile LAS unsigned* st) {
    XcdBarrier b; b.bar = bar; b.x = xb_xcc_id(); b.st = st;
    if (threadIdx.x == 0) (void)xb_add(&bar[XB_XCNT(b.x)], 1u);
    return b;
}
__device__ __forceinline__ void xcd_barrier_complete(unsigned* bar, unsigned x, unsigned& nloc, unsigned& nx) {
    const unsigned G = gridDim.x * gridDim.y * gridDim.z;
    unsigned sum, cnt, mine, sp = 0u;
    for (;;) {
        sum = 0u; cnt = 0u; mine = 0u;
#pragma unroll
        for (unsigned j = 0; j < 16; ++j) { const unsigned c = xb_ld(&bar[XB_XCNT(j)]); sum += c; cnt += (c > 0u) ? 1u : 0u; mine = (j == x) ? c : mine; }
        if (sum == G) break;
        __builtin_amdgcn_s_sleep(1);
        if ((++sp & 255u) == 0u) { if (xb_ld(&bar[XB_TMO])) break; if (sp > XB_SPIN_CAP) { atomicAdd(&bar[XB_TMO], 1u); break; } }
    }
    nloc = mine > 0u ? mine : 1u; nx = cnt > 0u ? cnt : 1u;
}

__device__ __forceinline__ void xcd_barrier(const XcdBarrier& b) {
    asm volatile("s_waitcnt vmcnt(0)" ::: "memory");
    __syncthreads();
    if (threadIdx.x == 0) {
        unsigned* bar = b.bar;
        __builtin_amdgcn_s_waitcnt(0);
        unsigned nloc = b.st[0], nx = b.st[1];
        if (nloc == 0u) { xcd_barrier_complete(bar, b.x, nloc, nx); b.st[0] = nloc; b.st[1] = nx; }
        const unsigned old = xb_add(&bar[XB_XSUB(b.x)], 1u);
        const unsigned gen = old / nloc;
        if (old + 1u == (gen + 1u) * nloc) {
            __builtin_amdgcn_fence(__ATOMIC_RELEASE, "agent");
            asm volatile("s_waitcnt vmcnt(0)" ::: "memory");
            const unsigned og = xb_add(&bar[XB_TOP], 1u);
            const unsigned tg = og / nx;
            if (og + 1u == (tg + 1u) * nx) xb_add(&bar[XB_TOPGEN], 1u);
            else XB_SPIN(xb_ld(&bar[XB_TOPGEN]) == tg, bar);
            __builtin_amdgcn_fence(__ATOMIC_ACQUIRE, "agent");
            xb_add(&bar[XB_XGEN(b.x)], 1u);
            asm volatile("s_waitcnt vmcnt(0)" ::: "memory");
        } else {
            XB_SPIN(xb_ld(&bar[XB_XGEN(b.x)]) == gen, bar);
            __builtin_amdgcn_fence(__ATOMIC_ACQUIRE, "agent");
            asm volatile("s_waitcnt vmcnt(0)" ::: "memory");
        }
    }
    __syncthreads();
}


__global__ void __launch_bounds__(512, 2) mega_fwd(Params p) {
    extern __shared__ __attribute__((aligned(16))) unsigned char lds_raw[];
    LAS unsigned char* lds = (LAS unsigned char*)lds_raw;
    unsigned char* ws = p.ws;
    const int G = gridDim.x, c = blockIdx.x;
    LAS unsigned* stw = (LAS unsigned*)(lds + LDS_BYTES - 16);
    if (threadIdx.x < 4) stw[threadIdx.x] = 0u;
    __syncthreads();
    const XcdBarrier xb = xcd_barrier_post((unsigned*)(ws + OFF_BAR), (volatile LAS unsigned*)stw);

    phase0(p, lds);
    xcd_barrier(xb);
    {
        pg8::Gemm g{(const bf16_t*)(ws + OFF_HREG), (const bf16_t*)(ws + OFF_WINT), MTOK, NIN, D, nullptr, nullptr}; pg8::StaticOrder S; S.init(MTOK, NIN, G, c);
        EpiIn E{(bf16_t*)(ws + OFF_P)};
        pg8::gemm_phase<EpiIn, pg8::StaticOrder>(lds, g, S, E);
        const int rem = S.nwg % G;
        if (rem == 0 || c >= rem) {
            const int wk = rem ? c - rem : c, nwk = rem ? G - rem : G;
            convert_matrix<false, true>(p.in[10], DL, D, (bf16_t*)(ws + OFF_WLRU), nullptr, lds, wk, nwk);
            convert_matrix<false, true>(p.in[12], DS, D, (bf16_t*)(ws + OFF_WSC), nullptr, lds, wk, nwk);
            convert_matrix<false, true>(p.in[13], D, D, (bf16_t*)(ws + OFF_WO), nullptr, lds, wk, nwk);
            convert_matrix<true, true>(p.in[15], D, NUP, (bf16_t*)(ws + OFF_WUP), p.in[14], lds, wk, nwk);
        }
    }
    xcd_barrier(xb);
    sc_phase(p);
    {
        float hloc[64], cumA[64], Aex = 1.f, hex = 0.f; unsigned gpk[32];
        const bool has_unit = c < LRU_UNITS;
        if (has_unit) { lru_partA(p, lds, c, hloc, cumA, Aex, hex, gpk); lru_partB(p, c, hloc, cumA, Aex, hex, gpk); }
    }
    xcd_barrier(xb);
    {
        pg8::StaticOrder S; S.init(MTOK, D, G, c);
        pg8::Gemm g{(const bf16_t*)(ws + OFF_HREG), (const bf16_t*)(ws + OFF_WLRU), MTOK, D, DL, (const bf16_t*)(ws + OFF_HREG) + (size_t)MTOK * DL, (const bf16_t*)(ws + OFF_WSC)};
        EpiMix E{(const bf16_t*)(ws + OFF_P), (bf16_t*)(ws + OFF_MRG)};
        pg8::gemm_phase<EpiMix, pg8::StaticOrder, 2>(lds, g, S, E);
    }
    xcd_barrier(xb);
    {
        pg8::Gemm g{(const bf16_t*)(ws + OFF_MRG), (const bf16_t*)(ws + OFF_WO), MTOK, D, D, nullptr, nullptr}; pg8::StaticOrder S; S.init(MTOK, D, G, c);
        EpiO E{p.in[0], (bf16_t*)(ws + OFF_HREG), (float*)(ws + OFF_SQ)};
        pg8::gemm_phase<EpiO, pg8::StaticOrder>(lds, g, S, E);
    }
    xcd_barrier(xb);
    {
        pg8::Gemm g{(const bf16_t*)(ws + OFF_HREG), (const bf16_t*)(ws + OFF_WUP), MTOK, NUP, D, nullptr, nullptr}; pg8::StaticOrder S; S.init(MTOK, NUP, G, c);
        int last_pm = -1, epi_ui = 0;
        {
            LAS float* wl0 = (LAS float*)(lds + pg8::STAGE_BYTES) + 2048 + 256;
            Unit uu; const int t0 = opaque_tid();
            for (int i = 0; i < 6 && S.next(i, uu); ++i)
                if (t0 < 192) { const int k = t0 >> 6, q = t0 & 63, bj = q >> 5;
                    *(LAS f32x4*)(wl0 + 768 * i + k * 256 + 4 * q) = *(const f32x4*)(p.in[16] + k * NUP + bj * DFF + uu.pn * 128 + ((4 * q) & 127)); }
            __syncthreads();
        }
        EpiUpConv E{(const float*)(ws + OFF_SQ), (bf16_t*)(ws + OFF_FF), p.in[16], (float*)(ws + OFF_HALO), (LAS float*)(lds + pg8::STAGE_BYTES), &last_pm, &epi_ui};
        pg8::gemm_phase<EpiUpConv, pg8::StaticOrder>(lds, g, S, E);
        const int rem = S.nwg % G;
        if (rem == 0) convert_matrix<false, true>(p.in[17], DFF, D, (bf16_t*)(ws + OFF_WDN), nullptr, lds, c, G);
        else if (c >= rem) convert_matrix<false, true>(p.in[17], DFF, D, (bf16_t*)(ws + OFF_WDN), nullptr, lds, c - rem, G - rem);
    }
    xcd_barrier(xb);
    {
        pg8::Gemm g{(const bf16_t*)(ws + OFF_FF), (const bf16_t*)(ws + OFF_WDN), MTOK, D, DFF, nullptr, nullptr}; pg8::StaticOrder S; S.init(MTOK, D, G, c);
        { Unit u; for (int ui = 0; S.next(ui, u); ++ui) ff_fixup((const float*)(ws + OFF_HALO), p.in[16], (bf16_t*)(ws + OFF_FF), u.pm);
          asm volatile("s_waitcnt vmcnt(0)" ::: "memory"); __syncthreads(); }
        EpiDnNorm E{p.out, (const bf16_t*)(ws + OFF_HREG), p.in[18], (float*)(ws + OFF_SQ2), (unsigned*)(ws + OFF_CNT)};
        pg8::gemm_phase<EpiDnNorm, pg8::StaticOrder>(lds, g, S, E);
    }
}

extern "C" void kernel_launch(void* const* d_in, const int* in_sizes, int n_in, void* d_out, int out_size, void* d_ws, size_t ws_size, hipStream_t stream) {
    static int grid_blocks = 0;
    if (grid_blocks == 0) {
        if (n_in != 19 || out_size != MTOK * D || ws_size < WS_END) { fprintf(stderr, "kernel_launch: unexpected shapes (n_in %d out %d ws %zu, need %zu)\n", n_in, out_size, ws_size, (size_t)WS_END); grid_blocks = -1; return; }
        int dev = 0, cus = 0, per_cu = 0;
        (void)hipGetDevice(&dev);
        (void)hipDeviceGetAttribute(&cus, hipDeviceAttributeMultiprocessorCount, dev);
        (void)hipFuncSetAttribute((const void*)mega_fwd, hipFuncAttributeMaxDynamicSharedMemorySize, LDS_BYTES);
        (void)hipOccupancyMaxActiveBlocksPerMultiprocessor(&per_cu, (const void*)mega_fwd, 512, LDS_BYTES);
        if (per_cu < 1) { fprintf(stderr, "kernel_launch: occupancy query says %d blocks/CU: nothing launched\n", per_cu); grid_blocks = -1; return; }
        if (cus < LRU_UNITS) { fprintf(stderr, "kernel_launch: needs >= %d CUs (got %d)\n", LRU_UNITS, cus); grid_blocks = -1; return; }
        grid_blocks = cus * (per_cu < 1 ? per_cu : 1);
    }
    if (grid_blocks < 0) return;
    Params p{};
    for (int i = 0; i < 19; ++i) p.in[i] = (const float*)d_in[i];
    p.out = (float*)d_out; p.ws = (unsigned char*)d_ws;
    (void)hipMemsetAsync((char*)d_ws + OFF_BAR, 0, XCD_BAR_WORDS * 4, stream);
    void* args[] = {&p};
    hipError_t e = hipLaunchCooperativeKernel((const void*)mega_fwd, dim3(grid_blocks), dim3(512), args, LDS_BYTES, stream);
    if (e != hipSuccess) fprintf(stderr, "cooperative launch failed: %s (grid %d)\n", hipGetErrorString(e), grid_blocks);
}
```
